# Optimizing an MI355X kernel written in HIP

```python
import jax, jax.numpy as jnp
from jax import lax
import numpy as np

D_MODEL = 1024
BATCH = 2
SEQ = 8192
DEPTH = 2

D_MIX = D_MODEL
N_GROUPS = 4
GROUP_W = D_MIX // N_GROUPS
HEAD_DIM = 64
ROT_DIM = HEAD_DIM // 4
ROPE_THETA = 500000.0
EPS = 1e-6
D_FF = 2816
SG_HEADS = GROUP_W // HEAD_DIM
SG_CHUNK = 128
SC_WIDTH = 3
DSA_HEADS = GROUP_W // HEAD_DIM
KV_LATENT = 128
IDX_HEADS = 4
IDX_DIM = 64
IDX_TOPK = 256
DSA_BLOCK = 128
GDN_HEADS = GROUP_W // HEAD_DIM
GDN_CONV = 4
GDN_CHUNK = 64
MEM_LEN = 256
XA_HEADS = 4
XA_HEAD_DIM = D_MODEL // XA_HEADS

SPLIT_SIZES = (2 * GROUP_W, 3 * GROUP_W, GROUP_W, KV_LATENT, IDX_HEADS * IDX_DIM, IDX_DIM,
               IDX_HEADS, 3 * GROUP_W, GDN_HEADS, GDN_HEADS, GROUP_W)
N_MIX_IN = sum(SPLIT_SIZES)

kernel_name = "hybrid_parallel_group_decoder"


def rmsnorm(x, g):
    xf = x.astype(jnp.float32)
    y = xf * lax.rsqrt(jnp.mean(xf * xf, axis=-1, keepdims=True) + EPS)
    return (y * g.astype(jnp.float32)).astype(x.dtype)


def swiglu(h, wg, wu, wd):
    return (jax.nn.silu(h @ wg) * (h @ wu)) @ wd


def causal_dwconv(x, w):
    K = w.shape[-1]
    S = x.shape[1]
    xp = jnp.pad(x, ((0, 0), (K - 1, 0), (0, 0)))
    return sum(xp[:, j:j + S, :] * w[:, j] for j in range(K))


def partial_rope(x, pos):
    half = ROT_DIM // 2
    inv = ROPE_THETA ** (-jnp.arange(half, dtype=jnp.float32) * (2.0 / ROT_DIM))
    ang = pos.astype(jnp.float32)[:, :, None, None] * inv
    cos, sin = jnp.cos(ang), jnp.sin(ang)
    xf = x.astype(jnp.float32)
    x1, x2, xp = xf[..., :half], xf[..., half:ROT_DIM], xf[..., ROT_DIM:]
    return jnp.concatenate([x1 * cos - x2 * sin, x2 * cos + x1 * sin, xp], -1).astype(x.dtype)


def spatial_gating(uv, norm_g, w_s, b_s):
    Bsz, S, _ = uv.shape
    u, v = jnp.split(jax.nn.gelu(uv), 2, axis=-1)
    v = rmsnorm(v, norm_g)
    n = S // SG_CHUNK
    vc = v.reshape(Bsz, n, SG_CHUNK, SG_HEADS, HEAD_DIM)
    causal = jnp.tril(jnp.ones((SG_CHUNK, SG_CHUNK), bool))
    w = jnp.where(causal, w_s, 0.0).astype(v.dtype)
    mixed = jnp.einsum('hts,bnshd->bnthd', w, vc) + b_s.T.astype(v.dtype)[None, None, :, :, None]
    return u * mixed.reshape(Bsz, S, GROUP_W)


def short_gated_conv(bch, w_conv):
    b, c, h = jnp.split(bch, 3, axis=-1)
    return b * causal_dwconv(c * h, w_conv)


def sparse_indexed_attention(q, ckv, iq, ik, iw, pos, kv_norm, w_uk, w_uv, ik_norm):
    Bsz, S, _ = q.shape
    c = rmsnorm(ckv, kv_norm)
    k = partial_rope((c @ w_uk).reshape(Bsz, S, DSA_HEADS, HEAD_DIM), pos)
    v = (c @ w_uv).reshape(Bsz, S, DSA_HEADS, HEAD_DIM)
    q = partial_rope(q.reshape(Bsz, S, DSA_HEADS, HEAD_DIM), pos)
    iq = partial_rope(iq.reshape(Bsz, S, IDX_HEADS, IDX_DIM), pos)
    ik = partial_rope(rmsnorm(ik, ik_norm)[:, :, None, :], pos)[:, :, 0, :]
    iw = iw.astype(jnp.float32) * (IDX_HEADS ** -0.5)
    topk = min(IDX_TOPK, S // 4)
    nb = S // DSA_BLOCK
    kv = jnp.concatenate([k, v], axis=-1)
    key_idx = jnp.arange(S)

    def to_blocks(t):
        return jnp.swapaxes(t.reshape(Bsz, nb, DSA_BLOCK, *t.shape[2:]), 0, 1)

    def block(args):
        qb, iqb, iwb, start = args
        qpos = start + jnp.arange(DSA_BLOCK)
        s = jnp.einsum('bqhd,bsd->bqhs', iqb, ik, preferred_element_type=jnp.float32) * (IDX_DIM ** -0.5)
        score = jnp.einsum('bqh,bqhs->bqs', iwb, jax.nn.relu(s))
        score = jnp.where(key_idx[None, None, :] <= qpos[None, :, None], score, -jnp.inf)
        _, idx = lax.top_k(score, topk)
        kvg = jax.vmap(lambda a, i: a[i])(kv, idx)
        kg, vg = kvg[..., :HEAD_DIM], kvg[..., HEAD_DIM:]
        logits = jnp.einsum('bqhd,bqkhd->bqhk', qb, kg, preferred_element_type=jnp.float32) * (HEAD_DIM ** -0.5)
        valid = (idx <= qpos[None, :, None])[:, :, None, :]
        p = jax.nn.softmax(jnp.where(valid, logits, -jnp.inf), axis=-1)
        return jnp.einsum('bqhk,bqkhd->bqhd', p.astype(vg.dtype), vg)

    starts = jnp.arange(nb) * DSA_BLOCK
    out = lax.map(block, (to_blocks(q), to_blocks(iq), to_blocks(iw), starts))
    return jnp.swapaxes(out, 0, 1).reshape(Bsz, S, GROUP_W)


def chunk_gated_delta_rule(q, k, v, g, beta):
    Bsz, S, H, dk = q.shape
    dv = v.shape[-1]
    C = GDN_CHUNK
    n = S // C

    def blk(t):
        return jnp.moveaxis(t.reshape(Bsz, n, C, H, -1), 3, 1)

    q, k, v = blk(q), blk(k), blk(v)
    beta = blk(beta[..., None])[..., 0]
    gc = jnp.cumsum(blk(g[..., None])[..., 0], axis=-1)
    incl = jnp.tril(jnp.ones((C, C), bool))
    strict = jnp.tril(jnp.ones((C, C), bool), -1)
    decay = jnp.exp(jnp.where(incl, gc[..., :, None] - gc[..., None, :], -jnp.inf))
    kb = k * beta[..., None]
    a_mat = jnp.where(strict, jnp.einsum('bhnid,bhnjd->bhnij', kb, k) * decay, 0.0)
    lhs = a_mat + jnp.eye(C, dtype=jnp.float32)
    rhs = jnp.concatenate([v * beta[..., None], kb * jnp.exp(gc)[..., None]], axis=-1)
    sol = lax.linalg.triangular_solve(lhs, rhs, left_side=True, lower=True, unit_diagonal=True)
    u, w = sol[..., :dv], sol[..., dv:]
    attn = jnp.where(incl, jnp.einsum('bhnid,bhnjd->bhnij', q, k) * decay, 0.0)

    def step(state, xs):
        q_i, k_i, u_i, w_i, attn_i, gc_i = xs
        v_new = u_i - jnp.einsum('bhck,bhkv->bhcv', w_i, state)
        o_i = (jnp.einsum('bhck,bhkv->bhcv', q_i * jnp.exp(gc_i)[..., None], state)
               + jnp.einsum('bhcs,bhsv->bhcv', attn_i, v_new))
        g_last = gc_i[..., -1:]
        state = (state * jnp.exp(g_last)[..., None]
                 + jnp.einsum('bhck,bhcv->bhkv', k_i * jnp.exp(g_last - gc_i)[..., None], v_new))
        return state, o_i

    xs = tuple(jnp.moveaxis(t, 2, 0) for t in (q, k, u, w, attn, gc))
    state0 = jnp.zeros((Bsz, H, dk, dv), jnp.float32)
    _, o = lax.scan(step, state0, xs)
    return o.transpose(1, 0, 3, 2, 4).reshape(Bsz, S, H, dv)


def gated_deltanet(qkv, a, b, gate, w_conv, a_log, dt_bias, out_norm):
    Bsz, S, _ = qkv.shape
    dtype = qkv.dtype
    qkv = jax.nn.silu(causal_dwconv(qkv, w_conv))
    q, k, v = [t.reshape(Bsz, S, GDN_HEADS, HEAD_DIM).astype(jnp.float32) for t in jnp.split(qkv, 3, axis=-1)]
    q = q * lax.rsqrt(jnp.sum(q * q, axis=-1, keepdims=True) + EPS)
    k = k * lax.rsqrt(jnp.sum(k * k, axis=-1, keepdims=True) + EPS)
    beta = jax.nn.sigmoid(b.astype(jnp.float32))
    g = -jnp.exp(a_log.astype(jnp.float32)) * jax.nn.softplus(a.astype(jnp.float32) + dt_bias.astype(jnp.float32))
    o = chunk_gated_delta_rule(q * (HEAD_DIM ** -0.5), k, v, g, beta)
    o = rmsnorm(o, out_norm) * jax.nn.silu(gate.reshape(Bsz, S, GDN_HEADS, HEAD_DIM).astype(jnp.float32))
    return o.reshape(Bsz, S, GROUP_W).astype(dtype)


def memory_cross_attention(h, m, wq, wk, wv, wo):
    Bsz, S, _ = h.shape
    q = (h @ wq).reshape(Bsz, S, XA_HEADS, XA_HEAD_DIM)
    k = (m @ wk).reshape(Bsz, -1, XA_HEADS, XA_HEAD_DIM)
    v = (m @ wv).reshape(Bsz, -1, XA_HEADS, XA_HEAD_DIM)
    logits = jnp.einsum('bqhd,bkhd->bhqk', q, k, preferred_element_type=jnp.float32) * (XA_HEAD_DIM ** -0.5)
    p = jax.nn.softmax(logits, axis=-1)
    o = jnp.einsum('bhqk,bkhd->bqhd', p.astype(v.dtype), v).reshape(Bsz, S, D_MODEL)
    return o @ wo


def setup_inputs(seed: int = 0) -> dict:
    key = jax.random.key(seed)
    ks = iter(list(jax.random.split(key, 48)))
    L = DEPTH

    def nrm(shape, fan_in):
        return jax.random.normal(next(ks), shape, jnp.float32) * (fan_in ** -0.5)

    def gain(shape):
        return 1.0 + 0.05 * jax.random.normal(next(ks), shape, jnp.float32)

    x = jax.random.normal(next(ks), (BATCH, SEQ, D_MODEL), jnp.float32)
    mem = jax.random.normal(next(ks), (BATCH, MEM_LEN, D_MODEL), jnp.float32)
    offset = jax.random.randint(next(ks), (BATCH, 1), 0, 4096, dtype=jnp.int32)
    positions = offset + jnp.arange(SEQ, dtype=jnp.int32)[None, :]
    d = {"x": x, "mem": mem, "positions": positions}
    d["ffn1_norm"] = gain((L, D_MODEL))
    d["ffn1_wg"] = nrm((L, D_MODEL, D_FF), D_MODEL)
    d["ffn1_wu"] = nrm((L, D_MODEL, D_FF), D_MODEL)
    d["ffn1_wd"] = nrm((L, D_FF, D_MODEL), D_FF)
    d["mix_norm"] = gain((L, D_MODEL))
    d["w_mix_in"] = nrm((L, D_MODEL, N_MIX_IN), D_MODEL)
    d["w_mix_out"] = nrm((L, D_MIX, D_MODEL), D_MIX)
    d["sg_norm"] = gain((L, GROUP_W))
    d["sg_w"] = nrm((L, SG_HEADS, SG_CHUNK, SG_CHUNK), SG_CHUNK)
    d["sg_b"] = 1.0 + 0.1 * jax.random.normal(next(ks), (L, SG_HEADS, SG_CHUNK), jnp.float32)
    d["sc_conv"] = nrm((L, GROUP_W, SC_WIDTH), SC_WIDTH)
    d["kv_norm"] = gain((L, KV_LATENT))
    d["w_uk"] = nrm((L, KV_LATENT, GROUP_W), KV_LATENT)
    d["w_uv"] = nrm((L, KV_LATENT, GROUP_W), KV_LATENT)
    d["idx_k_norm"] = gain((L, IDX_DIM))
    d["gdn_conv"] = nrm((L, 3 * GROUP_W, GDN_CONV), GDN_CONV)
    d["gdn_a_log"] = jnp.log(jax.random.uniform(next(ks), (L, GDN_HEADS), jnp.float32, 1.0, 16.0))
    dt = jnp.exp(jax.random.uniform(next(ks), (L, GDN_HEADS), jnp.float32, np.log(1e-3), np.log(1e-1)))
    d["gdn_dt_bias"] = dt + jnp.log(-jnp.expm1(-dt))
    d["gdn_out_norm"] = gain((L, HEAD_DIM))
    d["xa_norm"] = gain((L, D_MODEL))
    d["mem_norm"] = gain((L, D_MODEL))
    d["xa_wq"] = nrm((L, D_MODEL, D_MODEL), D_MODEL)
    d["xa_wk"] = nrm((L, D_MODEL, D_MODEL), D_MODEL)
    d["xa_wv"] = nrm((L, D_MODEL, D_MODEL), D_MODEL)
    d["xa_wo"] = nrm((L, D_MODEL, D_MODEL), D_MODEL)
    d["ffn2_norm"] = gain((L, D_MODEL))
    d["ffn2_wg"] = nrm((L, D_MODEL, D_FF), D_MODEL)
    d["ffn2_wu"] = nrm((L, D_MODEL, D_FF), D_MODEL)
    d["ffn2_wd"] = nrm((L, D_FF, D_MODEL), D_FF)
    d["final_norm"] = gain((D_MODEL,))
    return d


def reference(x, mem, positions, ffn1_norm, ffn1_wg, ffn1_wu, ffn1_wd, mix_norm, w_mix_in, w_mix_out,
              sg_norm, sg_w, sg_b, sc_conv, kv_norm, w_uk, w_uv, idx_k_norm, gdn_conv, gdn_a_log,
              gdn_dt_bias, gdn_out_norm, xa_norm, mem_norm, xa_wq, xa_wk, xa_wv, xa_wo,
              ffn2_norm, ffn2_wg, ffn2_wu, ffn2_wd, final_norm):
    split_points = [int(p) for p in np.cumsum(SPLIT_SIZES)[:-1]]
    for l in range(DEPTH):
        x = x + 0.5 * swiglu(rmsnorm(x, ffn1_norm[l]), ffn1_wg[l], ffn1_wu[l], ffn1_wd[l])
        h = rmsnorm(x, mix_norm[l])
        (p_sg, p_sc, p_q, p_ckv, p_iq, p_ik, p_iw,
         p_gqkv, p_ga, p_gb, p_gg) = jnp.split(h @ w_mix_in[l], split_points, axis=-1)
        y_a = spatial_gating(p_sg, sg_norm[l], sg_w[l], sg_b[l])
        y_b = short_gated_conv(p_sc, sc_conv[l])
        y_c = sparse_indexed_attention(p_q, p_ckv, p_iq, p_ik, p_iw, positions,
                                       kv_norm[l], w_uk[l], w_uv[l], idx_k_norm[l])
        y_d = gated_deltanet(p_gqkv, p_ga, p_gb, p_gg, gdn_conv[l], gdn_a_log[l],
                             gdn_dt_bias[l], gdn_out_norm[l])
        x = x + jnp.concatenate([y_a, y_b, y_c, y_d], axis=-1) @ w_mix_out[l]
        x = x + memory_cross_attention(rmsnorm(x, xa_norm[l]), rmsnorm(mem, mem_norm[l]),
                                       xa_wq[l], xa_wk[l], xa_wv[l], xa_wo[l])
        x = x + 0.5 * swiglu(rmsnorm(x, ffn2_norm[l]), ffn2_wg[l], ffn2_wu[l], ffn2_wd[l])
    return rmsnorm(x, final_norm)
```

```cpp
#include <hip/hip_runtime.h>
#include <hip/hip_cooperative_groups.h>
#include <cstdio>
#include <cstdint>
namespace cg = cooperative_groups;

#define LAS __attribute__((address_space(3)))
#define DI __device__ __forceinline__
typedef unsigned short bf16_t;
typedef short bf16x8 __attribute__((ext_vector_type(8)));
typedef float f32x4 __attribute__((ext_vector_type(4)));
typedef float f32x2 __attribute__((ext_vector_type(2)));
typedef float f32x16 __attribute__((ext_vector_type(16)));
typedef unsigned u32x4 __attribute__((ext_vector_type(4)));
typedef unsigned u32x2 __attribute__((ext_vector_type(2)));
typedef __bf16 bf2_t __attribute__((ext_vector_type(2)));

constexpr int BATCH = 2, SEQ = 8192, DM = 1024, MTOK = BATCH * SEQ, FF = 2816, DEPTH = 2;
constexpr int NMIX = 3020, NMIXP = 3072, MEMLEN = 256, MEMROWS = BATCH * MEMLEN;
constexpr float EPS = 1e-6f;

DI unsigned pk2(float lo, float hi) { f32x2 v = {lo, hi}; bf2_t b = __builtin_convertvector(v, bf2_t); return __builtin_bit_cast(unsigned, b); }
DI float bf2f(unsigned short u) { return __uint_as_float(((unsigned)u) << 16); }
DI float bflo(unsigned u) { return __uint_as_float(u << 16); }
DI float bfhi(unsigned u) { return __uint_as_float(u & 0xffff0000u); }
DI float silu_f(float x) { return x * __builtin_amdgcn_rcpf(1.f + __expf(-x)); }
DI float gelu_tanh(float x) { const float u = 0.7978845608028654f * (x + 0.044715f * x * x * x); const float t = 1.f - 2.f * __builtin_amdgcn_rcpf(1.f + __expf(2.f * u)); return 0.5f * x * (1.f + t); }
template <int X> DI float shx(float v) { static_assert(X == 1 || X == 2 || X == 4 || X == 8 || X == 16, "xor within 32 lanes"); return __int_as_float(__builtin_amdgcn_ds_swizzle(__float_as_int(v), (X << 10) | 0x1f)); }
DI float xsum32(float v) { auto r = __builtin_amdgcn_permlane32_swap(__float_as_uint(v), __float_as_uint(v), false, false); return __uint_as_float(r[0]) + __uint_as_float(r[1]); }
DI float xmax32(float v) { auto r = __builtin_amdgcn_permlane32_swap(__float_as_uint(v), __float_as_uint(v), false, false); return fmaxf(__uint_as_float(r[0]), __uint_as_float(r[1])); }
DI float wave_sum(float v) { v += shx<1>(v); v += shx<2>(v); v += shx<4>(v); v += shx<8>(v); v += shx<16>(v); return xsum32(v); }
namespace pg8 {
#define PG8_LAS __attribute__((address_space(3)))
typedef unsigned short bf16_t;
typedef short bf16x8 __attribute__((ext_vector_type(8)));
typedef float f32x4 __attribute__((ext_vector_type(4)));
typedef unsigned u32x4 __attribute__((ext_vector_type(4)));
constexpr int BM = 256, BK = 64, HALF = 128, HTB = HALF * BK * 2  , STAGE_BYTES = 8 * HTB, NXCD = 8, WGM = 8;

__host__ __device__ __forceinline__ int lds_byte(int r, int c) { const int st = (r >> 4) * 2 + (c >> 5), rr = r & 15, cc = c & 31, ob = rr * 64 + cc * 2; return st * 1024 + (ob ^ (((ob >> 9) & 1) << 5)); }
__host__ __device__ __forceinline__ void stage_rc(int b, int& R, int& C) { const int st = b / 1024, sb = b % 1024, swz = sb ^ (((sb >> 9) & 1) << 5); R = (st >> 1) * 16 + swz / 64; C = (st & 1) * 32 + (swz % 64) / 2; }
__host__ __device__ __forceinline__ int perm32(int rho) { const int n = rho >> 4, i = rho & 15; return 8 * (i >> 2) + 4 * n + (i & 3); }

struct Unit { int pm, pn; };
struct Gemm { const bf16_t* A; const bf16_t* Bt; int M, N, K; };

struct StaticOrder {
    int nM, nN, nwg, G, c;
    __host__ __device__ void init(int M, int N, int G_, int c_) { nM = M / BM; nN = N / BM; nwg = nM * nN; G = G_; c = c_; }
    __host__ __device__ bool next(int i, Unit& u) const {
        const long L = (long)i * G + c; if (L >= nwg) return false;
        int wgid = (int)L; { const int q = nwg / NXCD, r = nwg % NXCD, xcd = wgid % NXCD, off = wgid / NXCD; wgid = (xcd < r ? xcd * (q + 1) : r * (q + 1) + (xcd - r) * q) + off; }
        const int nig = WGM * nN, gid = wgid / nig, fm = gid * WGM, gsz = (nM - fm) < WGM ? (nM - fm) : WGM;
        u.pm = fm + ((wgid % nig) % gsz); u.pn = (wgid % nig) / gsz; return true;
    }
    __device__ __forceinline__ void a_ready(const Unit&) const {}
    __device__ __forceinline__ void done(const Unit&) const {}
};


__device__ __forceinline__ void load_rstd(const float* part, int row0, int fq, float (&rs)[2][4]) {
#pragma unroll
    for (int ai = 0; ai < 2; ++ai)
#pragma unroll
        for (int m = 0; m < 4; ++m) {
            const f32x4 p = *(const f32x4*)(part + (size_t)(row0 + ai * HALF + m * 16) * 16 + 4 * fq);
            float s = (p[0] + p[1]) + (p[2] + p[3]);
            s += shx<16>(s); s = xsum32(s);
            rs[ai][m] = rsqrtf(s * (1.0f / 1024.0f) + 1e-6f);
        }
}
__device__ __forceinline__ void rstd_issue_(const float* part, int row0, int tid, f32x4& r0, f32x4& r1) {
    asm volatile("" : "+v"(tid));
    const float* p = part + (size_t)(row0 + (tid >> 1)) * 16 + 8 * (tid & 1); r0 = *(const f32x4*)p; r1 = *(const f32x4*)(p + 4);
}
__device__ __forceinline__ void rstd_finish_(LAS float* dst, int tid, const f32x4& r0, const f32x4& r1) {
    asm volatile("" : "+v"(tid));
    float s = ((r0[0] + r0[1]) + (r0[2] + r0[3])) + ((r1[0] + r1[1]) + (r1[2] + r1[3]));
    s += shx<1>(s);
    if (!(tid & 1)) dst[tid >> 1] = rsqrtf(s * (1.0f / 1024.0f) + 1e-6f);
}
__device__ __forceinline__ void read_rstd(const LAS float* rsl, int wr, int fr, float (&rs)[2][4]) {
#pragma unroll
    for (int ai = 0; ai < 2; ++ai)
#pragma unroll
        for (int m = 0; m < 4; ++m) rs[ai][m] = rsl[ai * HALF + wr * 64 + m * 16 + fr];
}
struct EpiSwiglu {
    static constexpr bool PERM = true, AFTER_DRAIN = false, RSTD = true;
    bf16_t* H; const float* part; int ldh;
    __device__ __forceinline__ void rstd_issue(const Unit& u, int tid, f32x4& r0, f32x4& r1) const { rstd_issue_(part, u.pm * BM, tid, r0, r1); }
    __device__ __forceinline__ void rstd_finish(LAS float* dst, int tid, const f32x4& r0, const f32x4& r1) const { rstd_finish_(dst, tid, r0, r1); }
    __device__ __forceinline__ void operator()(const f32x4 (&acc)[2][2][4][2], const Unit& u, int wr, int wc, int fr, int fq, const LAS float* rsl) const {
        float rs[2][4]; read_rstd(rsl, wr, fr, rs);
        const int col0 = u.pn * HALF + wc * 32 + 8 * fq;
#pragma unroll
        for (int ai = 0; ai < 2; ++ai)
#pragma unroll
            for (int m = 0; m < 4; ++m) {
                const float r = rs[ai][m];
                float hv[8];
#pragma unroll
                for (int n = 0; n < 2; ++n)
#pragma unroll
                    for (int e = 0; e < 4; ++e) { const float g = acc[ai][0][m][n][e] * r, up = acc[ai][1][m][n][e] * r; hv[4 * n + e] = silu_f(g) * up; }
                u32x4 w; w.x = pk2(hv[0], hv[1]); w.y = pk2(hv[2], hv[3]); w.z = pk2(hv[4], hv[5]); w.w = pk2(hv[6], hv[7]);
                *(u32x4*)(H + (size_t)(u.pm * BM + ai * HALF + wr * 64 + m * 16 + fr) * ldh + col0) = w;
            }
    }
};
struct EpiResid {
    static constexpr bool PERM = true, AFTER_DRAIN = false, RSTD = false;
    const float* base32; bf16_t* xb; float* part; float scale; bool dry;
    __device__ __forceinline__ void finish(const f32x4 (&acc)[2][2][4][2], const f32x4 (&bv)[4][2][2], const Unit& u, int ai, int wr, int wc, int fr, int fq, float sc_) const {
#pragma unroll
        for (int m = 0; m < 4; ++m) {
            const int row = u.pm * BM + ai * HALF + wr * 64 + m * 16 + fr;
            float ss = 0.f;
#pragma unroll
            for (int bj = 0; bj < 2; ++bj) {
                const size_t off = (size_t)row * 1024 + u.pn * BM + bj * HALF + wc * 32 + 8 * fq;
                const f32x4 x0 = bv[m][bj][0] + acc[ai][bj][m][0] * sc_, x1 = bv[m][bj][1] + acc[ai][bj][m][1] * sc_;
                u32x4 w; w.x = pk2(x0[0], x0[1]); w.y = pk2(x0[2], x0[3]); w.z = pk2(x1[0], x1[1]); w.w = pk2(x1[2], x1[3]);
                *(u32x4*)(xb + off) = w;
                ss += (x0[0] * x0[0] + x0[1] * x0[1]) + (x0[2] * x0[2] + x0[3] * x0[3]) + (x1[0] * x1[0] + x1[1] * x1[1]) + (x1[2] * x1[2] + x1[3] * x1[3]);
            }
            ss += shx<16>(ss); ss = xsum32(ss);
            if (fq == 0) part[(size_t)row * 16 + u.pn * 4 + wc] = ss;
        }
    }
    __device__ __forceinline__ void operator()(const f32x4 (&acc)[2][2][4][2], const Unit& u, int wr, int wc, int fr, int fq, const LAS float*) const {
        const float sc_ = dry ? 0.f : scale;
        asm volatile("" : "+v"(fr), "+v"(fq), "+v"(wc), "+v"(wr));
        if (base32) {
#pragma unroll
            for (int ai = 0; ai < 2; ++ai) {
                f32x4 bv[4][2][2];
#pragma unroll
                for (int m = 0; m < 4; ++m)
#pragma unroll
                    for (int bj = 0; bj < 2; ++bj) {
                        const size_t off = (size_t)(u.pm * BM + ai * HALF + wr * 64 + m * 16 + fr) * 1024 + u.pn * BM + bj * HALF + wc * 32 + 8 * fq;
                        bv[m][bj][0] = *(const f32x4*)(base32 + off); bv[m][bj][1] = *(const f32x4*)(base32 + off + 4);
                    }
                asm volatile("" ::: "memory");
                finish(acc, bv, u, ai, wr, wc, fr, fq, sc_);
                asm volatile("" ::: "memory");
            }
        } else {
            u32x4 raw[2][4][2];
#pragma unroll
            for (int ai = 0; ai < 2; ++ai)
#pragma unroll
                for (int m = 0; m < 4; ++m)
#pragma unroll
                    for (int bj = 0; bj < 2; ++bj) {
                        const size_t off = (size_t)(u.pm * BM + ai * HALF + wr * 64 + m * 16 + fr) * 1024 + u.pn * BM + bj * HALF + wc * 32 + 8 * fq;
                        raw[ai][m][bj] = *(const u32x4*)(xb + off);
                    }
            asm volatile("" ::: "memory");
#pragma unroll
            for (int ai = 0; ai < 2; ++ai) {
                f32x4 bv[4][2][2];
#pragma unroll
                for (int m = 0; m < 4; ++m)
#pragma unroll
                    for (int bj = 0; bj < 2; ++bj) {
                        bv[m][bj][0] = (f32x4){bflo(raw[ai][m][bj][0]), bfhi(raw[ai][m][bj][0]), bflo(raw[ai][m][bj][1]), bfhi(raw[ai][m][bj][1])};
                        bv[m][bj][1] = (f32x4){bflo(raw[ai][m][bj][2]), bfhi(raw[ai][m][bj][2]), bflo(raw[ai][m][bj][3]), bfhi(raw[ai][m][bj][3])};
                    }
                finish(acc, bv, u, ai, wr, wc, fr, fq, sc_);
            }
            asm volatile("" ::: "memory");
        }
    }
};
struct EpiScale {
    static constexpr bool PERM = true, AFTER_DRAIN = false, RSTD = true;
    bf16_t* O; int ldc; size_t plane; const float* part; float scale; float* Of; int f32_from;
    __device__ __forceinline__ void rstd_issue(const Unit& u, int tid, f32x4& r0, f32x4& r1) const { if (part) rstd_issue_(part, u.pm * BM, tid, r0, r1); }
    __device__ __forceinline__ void rstd_finish(LAS float* dst, int tid, const f32x4& r0, const f32x4& r1) const { if (part) rstd_finish_(dst, tid, r0, r1); }
    __device__ __forceinline__ void operator()(const f32x4 (&acc)[2][2][4][2], const Unit& u, int wr, int wc, int fr, int fq, const LAS float* rsl) const {
        float rs[2][4];
        if (part) read_rstd(rsl, wr, fr, rs);
        else {
#pragma unroll
            for (int ai = 0; ai < 2; ++ai)
#pragma unroll
                for (int m = 0; m < 4; ++m) rs[ai][m] = 1.f;
        }
        const bool tof32 = u.pn >= f32_from;
        bf16_t* dst = O + (size_t)u.pn * plane + (plane ? 0 : u.pn * BM);
#pragma unroll
        for (int ai = 0; ai < 2; ++ai)
#pragma unroll
            for (int m = 0; m < 4; ++m) {
                const int row = u.pm * BM + ai * HALF + wr * 64 + m * 16 + fr; const float r = rs[ai][m] * scale;
#pragma unroll
                for (int bj = 0; bj < 2; ++bj) {
                    const int col = bj * HALF + wc * 32 + 8 * fq;
                    const f32x4 v0 = acc[ai][bj][m][0] * r, v1 = acc[ai][bj][m][1] * r;
                    if (tof32) { float* p = Of + (size_t)row * 256 + col; *(f32x4*)p = v0; *(f32x4*)(p + 4) = v1; }
                    else { u32x4 w; w.x = pk2(v0[0], v0[1]); w.y = pk2(v0[2], v0[3]); w.z = pk2(v1[0], v1[1]); w.w = pk2(v1[2], v1[3]);
                        *(u32x4*)(dst + (size_t)row * ldc + col) = w; }
                }
            }
    }
};

template <class Epi, class Sched, bool ALIGN_EPI = false, bool SP2 = false>
__device__ __forceinline__ void gemm_phase(PG8_LAS unsigned char* lds, const Gemm g, const Sched& S, const Epi& E, const int tid) {
    const int  wid = __builtin_amdgcn_readfirstlane(tid >> 6), lane = tid & 63, wr = wid >> 2, wc = wid & 3, fr = lane & 15, fq = lane >> 4;
    const int K = g.K, nt = K / BK;
    unsigned voffA[2], voffB[2];
#pragma unroll
    for (int i = 0; i < 2; ++i) { int R, C; stage_rc(tid * 16 + i * 8192, R, C); const int Rb = Epi::PERM ? ((R & ~31) + perm32(R & 31)) : R;
        voffA[i] = (unsigned)(R * K + C) * 2u; voffB[i] = (unsigned)(Rb * K + C) * 2u; }
    const size_t kstep = (size_t)(BK * 2);
    const size_t hstep = (size_t)HALF * K * 2;
    const size_t tstep = 2 * hstep;
    const unsigned ldsw = (unsigned)wid * 1024u;
    const int aoff = lds_byte(wr * 64 + fr, fq * 8), boff = lds_byte(wc * 32 + fr, fq * 8);
#define PG8_SA(b, h) (((b) * 2 + (h)) * HTB)
#define PG8_SB(b, h) ((4 + (b) * 2 + (h)) * HTB)
#define PG8_STAGE(bufoff, gbase, voff) do { _Pragma("unroll") for (int _i = 0; _i < 2; ++_i) \
        __builtin_amdgcn_global_load_lds((const unsigned*)((const char*)(gbase) + (voff)[_i]), (PG8_LAS unsigned*)(lds + (bufoff) + ldsw + _i * 8192), 16, 0, 0); } while (0)
#define PG8_LDA(dst, b, h) do { _Pragma("unroll") for (int m = 0; m < 4; ++m) _Pragma("unroll") for (int k = 0; k < 2; ++k) dst[m][k] = *(const PG8_LAS bf16x8*)(lds + PG8_SA(b, h) + aoff + m * 2048 + k * 1024); } while (0)
#define PG8_LDB(dst, b, h) do { _Pragma("unroll") for (int n = 0; n < 2; ++n) _Pragma("unroll") for (int k = 0; k < 2; ++k) dst[n][k] = *(const PG8_LAS bf16x8*)(lds + PG8_SB(b, h) + boff + n * 2048 + k * 1024); } while (0)
#define PG8_MMA(ai, bj, At, Bt) do { __builtin_amdgcn_s_setprio(1); _Pragma("unroll") for (int m = 0; m < 4; ++m) _Pragma("unroll") for (int n = 0; n < 2; ++n) _Pragma("unroll") for (int k = 0; k < 2; ++k) \
        acc[ai][bj][m][n] = __builtin_amdgcn_mfma_f32_16x16x32_bf16(Bt[n][k], At[m][k], acc[ai][bj][m][n], 0, 0, 0); __builtin_amdgcn_s_setprio(0); } while (0)
#define PG8_WAIT_V(n) asm volatile("s_waitcnt vmcnt(" #n ")" ::: "memory")
#define PG8_WAIT_L(n) asm volatile("s_waitcnt lgkmcnt(" #n ")" ::: "memory")
#define PG8_BAR __builtin_amdgcn_s_barrier()
#define PG8_SCHED __builtin_amdgcn_sched_barrier(0)
    Unit cur, nxt; int ui = 0;
    if (!S.next(0, cur)) return;
    f32x4 acc[2][2][4][2];
#pragma unroll
    for (int a = 0; a < 2; ++a)
#pragma unroll
        for (int b = 0; b < 2; ++b)
#pragma unroll
            for (int m = 0; m < 4; ++m)
#pragma unroll
                for (int n = 0; n < 2; ++n) acc[a][b][m][n] = (f32x4){0.f, 0.f, 0.f, 0.f};
    bf16x8 At[4][2], B0[2][2], B1[2][2];
    const char* cA = (const char*)g.A + (size_t)cur.pm * tstep; const char* cB = (const char*)g.Bt + (size_t)cur.pn * tstep;
    S.a_ready(cur);
    PG8_LAS float* const rsl = (PG8_LAS float*)(lds + STAGE_BYTES);
    if constexpr (Epi::RSTD) { f32x4 r0_, r1_; E.rstd_issue(cur, tid, r0_, r1_); E.rstd_finish(rsl, tid, r0_, r1_); }
    if constexpr (SP2) {
        PG8_STAGE(PG8_SB(0, 0), cB, voffB); PG8_STAGE(PG8_SB(0, 1), cB + hstep, voffB); PG8_STAGE(PG8_SA(0, 0), cA, voffA); PG8_STAGE(PG8_SA(0, 1), cA + hstep, voffA);
        if (wr == 1) PG8_BAR;
        PG8_WAIT_V(2); PG8_BAR;
        PG8_STAGE(PG8_SB(1, 0), cB + kstep, voffB); PG8_STAGE(PG8_SA(1, 0), cA + kstep, voffA); PG8_STAGE(PG8_SB(1, 1), cB + hstep + kstep, voffB);
        PG8_WAIT_V(6); PG8_BAR;
    } else {
        PG8_STAGE(PG8_SB(0, 0), cB, voffB); PG8_STAGE(PG8_SA(0, 0), cA, voffA); PG8_STAGE(PG8_SB(0, 1), cB + hstep, voffB); PG8_STAGE(PG8_SA(0, 1), cA + hstep, voffA);
        if (wr == 1) PG8_BAR;
        PG8_WAIT_V(4); PG8_BAR;
        PG8_STAGE(PG8_SB(1, 0), cB + kstep, voffB); PG8_STAGE(PG8_SA(1, 0), cA + kstep, voffA); PG8_STAGE(PG8_SB(1, 1), cB + hstep + kstep, voffB);
        PG8_WAIT_V(6); PG8_BAR;
    }
    for (;;) {
        const bool has_next = S.next(ui + 1, nxt);
        const char* nA = has_next ? (const char*)g.A + (size_t)nxt.pm * tstep : cA; const char* nB = has_next ? (const char*)g.Bt + (size_t)nxt.pn * tstep : cB;
        for (int t = 0; t < nt; t += 2) {
            const bool last = (t == nt - 2);
            const char* a1 = cA + (size_t)(t + 1) * kstep;
            const char* a2 = last ? nA : cA + (size_t)(t + 2) * kstep; const char* b2 = last ? nB : cB + (size_t)(t + 2) * kstep;
            const char* a3 = a2 + kstep; const char* b3 = b2 + kstep;
            if (last && has_next) S.a_ready(nxt);
            if constexpr (SP2) {
            PG8_LDB(B0, 0, 0); PG8_LDB(B1, 0, 1); PG8_SCHED; PG8_LDA(At, 0, 0); PG8_STAGE(PG8_SA(1, 1), a1 + hstep, voffA);
            PG8_WAIT_V(8); PG8_WAIT_L(0); PG8_BAR; PG8_MMA(0, 0, At, B0); PG8_MMA(0, 1, At, B1); PG8_BAR; PG8_SCHED;
            PG8_LDA(At, 0, 1); PG8_STAGE(PG8_SB(0, 0), b2, voffB); PG8_STAGE(PG8_SB(0, 1), b2 + hstep, voffB); PG8_STAGE(PG8_SA(0, 0), a2, voffA);
            PG8_WAIT_V(8); PG8_WAIT_L(0); PG8_BAR; PG8_MMA(1, 0, At, B0); PG8_MMA(1, 1, At, B1); PG8_BAR; PG8_SCHED;
            PG8_LDB(B0, 1, 0); PG8_LDB(B1, 1, 1); PG8_SCHED; PG8_LDA(At, 1, 0); PG8_STAGE(PG8_SA(0, 1), a2 + hstep, voffA);
            PG8_WAIT_V(8); PG8_WAIT_L(0); PG8_BAR; PG8_MMA(0, 0, At, B0); PG8_MMA(0, 1, At, B1); PG8_BAR; PG8_SCHED;
            PG8_LDA(At, 1, 1); PG8_STAGE(PG8_SB(1, 0), b3, voffB); PG8_STAGE(PG8_SB(1, 1), b3 + hstep, voffB); PG8_STAGE(PG8_SA(1, 0), a3, voffA);
            PG8_WAIT_V(8); PG8_WAIT_L(0); PG8_BAR; PG8_MMA(1, 0, At, B0); PG8_MMA(1, 1, At, B1); PG8_BAR; PG8_SCHED;
            } else {
            PG8_LDB(B0, 0, 0); PG8_SCHED; PG8_LDA(At, 0, 0); PG8_STAGE(PG8_SA(1, 1), a1 + hstep, voffA);
            PG8_WAIT_L(8); PG8_BAR; PG8_WAIT_L(0); PG8_MMA(0, 0, At, B0); PG8_BAR; PG8_SCHED;
            PG8_LDB(B1, 0, 1); PG8_STAGE(PG8_SB(0, 0), b2, voffB);
            PG8_BAR; PG8_WAIT_L(0); PG8_MMA(0, 1, At, B1); PG8_BAR;
            PG8_LDA(At, 0, 1); PG8_STAGE(PG8_SA(0, 0), a2, voffA);
            PG8_BAR; PG8_WAIT_L(0); PG8_MMA(1, 0, At, B0); PG8_BAR; PG8_SCHED;
            PG8_STAGE(PG8_SB(0, 1), b2 + hstep, voffB);
            PG8_WAIT_V(6); PG8_BAR; PG8_MMA(1, 1, At, B1); PG8_BAR;
            PG8_LDB(B0, 1, 0); PG8_SCHED; PG8_LDA(At, 1, 0); PG8_STAGE(PG8_SA(0, 1), a2 + hstep, voffA);
            PG8_WAIT_L(8); PG8_BAR; PG8_WAIT_L(0); PG8_MMA(0, 0, At, B0); PG8_BAR; PG8_SCHED;
            PG8_LDB(B1, 1, 1); PG8_STAGE(PG8_SB(1, 0), b3, voffB);
            PG8_BAR; PG8_WAIT_L(0); PG8_MMA(0, 1, At, B1); PG8_BAR;
            PG8_LDA(At, 1, 1); PG8_STAGE(PG8_SA(1, 0), a3, voffA);
            PG8_BAR; PG8_WAIT_L(0); PG8_MMA(1, 0, At, B0); PG8_BAR; PG8_SCHED;
            PG8_STAGE(PG8_SB(1, 1), b3 + hstep, voffB);
            PG8_WAIT_V(6); PG8_BAR; PG8_MMA(1, 1, At, B1); PG8_BAR;
            }
        }
        if constexpr (ALIGN_EPI) { if (wr == 0) PG8_BAR; }
        if constexpr (!Epi::AFTER_DRAIN) {
            f32x4 r0_, r1_;
            if constexpr (Epi::RSTD) { if (has_next) E.rstd_issue(nxt, tid, r0_, r1_); }
            E(acc, cur, wr, wc, fr, fq, rsl + (ui & 1) * 256);
            if constexpr (Epi::RSTD) { if (has_next) E.rstd_finish(rsl + ((ui + 1) & 1) * 256, tid, r0_, r1_); }
            S.done(cur); }
        if (!has_next) break;
#pragma unroll
        for (int a = 0; a < 2; ++a)
#pragma unroll
            for (int b = 0; b < 2; ++b)
#pragma unroll
                for (int m = 0; m < 4; ++m)
#pragma unroll
                    for (int n = 0; n < 2; ++n) acc[a][b][m][n] = (f32x4){0.f, 0.f, 0.f, 0.f};
        cur = nxt; cA = nA; cB = nB; ++ui;
        if constexpr (ALIGN_EPI) { if (wr == 1) PG8_BAR; }
    }
    PG8_WAIT_V(0);
    if constexpr (!ALIGN_EPI) { if (wr == 0) PG8_BAR; }
    PG8_BAR;
    if constexpr (Epi::AFTER_DRAIN) { E.fused(acc, cur, wr, wc, fr, fq, lds, wid, lane); S.done(cur); }
#undef PG8_SA
#undef PG8_SB
#undef PG8_STAGE
#undef PG8_LDA
#undef PG8_LDB
#undef PG8_MMA
#undef PG8_WAIT_V
#undef PG8_WAIT_L
#undef PG8_BAR
#undef PG8_SCHED
}
}

#define GAS __attribute__((address_space(1)))
typedef GAS unsigned gu32;
#define XB_TMO      128
#define XB_XCNT(j)  (256  + 64 * (j))
#define XB_XSUB(j)  (1280 + 64 * (j))
#define XB_XGEN(j)  (2304 + 64 * (j))
#define XB_TOP      3328
#define XB_TOPGEN   3392
#define XCD_BAR_WORDS 3456
#define XB_SPIN_CAP (1u << 18)

__device__ __forceinline__ unsigned xb_ld(unsigned* p)              { return __hip_atomic_load(p, __ATOMIC_RELAXED, __HIP_MEMORY_SCOPE_AGENT); }
__device__ __forceinline__ unsigned xb_add(unsigned* p, unsigned v) { return __hip_atomic_fetch_add(p, v, __ATOMIC_RELAXED, __HIP_MEMORY_SCOPE_AGENT); }
__device__ __forceinline__ unsigned xb_xcc_id() { return (unsigned)__builtin_amdgcn_s_getreg((3 << 11) | 20) & 0xFu; }
#define XB_SPIN(cond, bar) do { unsigned _sp = 0; while (cond) { __builtin_amdgcn_s_sleep(1); \
    if ((++_sp & 255u) == 0u) { if (xb_ld(&(bar)[XB_TMO])) break; if (_sp > XB_SPIN_CAP) { atomicAdd(&(bar)[XB_TMO], 1u); break; } } } } while (0)

struct XcdBarrier {
    unsigned* bar; unsigned x;
    volatile LAS unsigned* st;
};

__device__ __forceinline__ XcdBarrier xcd_barrier_post(unsigned* bar, volatile LAS unsigned* st) {
    XcdBarrier b; b.bar = bar; b.x = xb_xcc_id(); b.st = st;
    if (threadIdx.x == 0) (void)xb_add(&bar[XB_XCNT(b.x)], 1u);
    return b;
}
__device__ __forceinline__ void xcd_barrier_complete(unsigned* bar, unsigned x, unsigned& nloc, unsigned& nx) {
    const unsigned G = gridDim.x * gridDim.y * gridDim.z;
    unsigned sum, cnt, mine, sp = 0u;
    for (;;) {
        sum = 0u; cnt = 0u; mine = 0u;
#pragma unroll
        for (unsigned j = 0; j < 16; ++j) { const unsigned c = xb_ld(&bar[XB_XCNT(j)]); sum += c; cnt += (c > 0u) ? 1u : 0u; mine = (j == x) ? c : mine; }
        if (sum == G) break;
        __builtin_amdgcn_s_sleep(1);
        if ((++sp & 255u) == 0u) { if (xb_ld(&bar[XB_TMO])) break; if (sp > XB_SPIN_CAP) { atomicAdd(&bar[XB_TMO], 1u); break; } }
    }
    nloc = mine > 0u ? mine : 1u; nx = cnt > 0u ? cnt : 1u;
}

__device__ __forceinline__ void xcd_barrier(const XcdBarrier& b, const int tid_) {
    asm volatile("s_waitcnt vmcnt(0)" ::: "memory");
    __syncthreads();
    if (tid_ == 0) {
        unsigned* bar = b.bar;
        __builtin_amdgcn_s_waitcnt(0);
        unsigned nloc = b.st[0], nx = b.st[1];
        if (nloc == 0u) { xcd_barrier_complete(bar, b.x, nloc, nx); b.st[0] = nloc; b.st[1] = nx; }
        const unsigned old = xb_add(&bar[XB_XSUB(b.x)], 1u);
        const unsigned gen = old / nloc;
        if (old + 1u == (gen + 1u) * nloc) {
            __builtin_amdgcn_fence(__ATOMIC_RELEASE, "agent");
            asm volatile("s_waitcnt vmcnt(0)" ::: "memory");
            const unsigned og = xb_add(&bar[XB_TOP], 1u);
            const unsigned tg = og / nx;
            if (og + 1u == (tg + 1u) * nx) xb_add(&bar[XB_TOPGEN], 1u);
            else XB_SPIN(xb_ld(&bar[XB_TOPGEN]) == tg, bar);
            __builtin_amdgcn_fence(__ATOMIC_ACQUIRE, "agent");
            xb_add(&bar[XB_XGEN(b.x)], 1u);
            asm volatile("s_waitcnt vmcnt(0)" ::: "memory");
        } else {
            XB_SPIN(xb_ld(&bar[XB_XGEN(b.x)]) == gen, bar);
            __builtin_amdgcn_fence(__ATOMIC_ACQUIRE, "agent");
            asm volatile("s_waitcnt vmcnt(0)" ::: "memory");
        }
    }
    __syncthreads();
}

constexpr size_t MiB = 1u << 20;
constexpr size_t WS_CTL = 0, CTL_BYTES = 1 * MiB;
constexpr size_t WS_SLOTA = 1 * MiB, WS_SLOTB = 12 * MiB;
constexpr size_t WS_WKV = 23 * MiB;
constexpr size_t WS_KMEM = 31 * MiB;
constexpr size_t WS_VMEMT = 33 * MiB;
constexpr size_t WS_MEMN = 35 * MiB;
constexpr size_t WS_ROPE = 37 * MiB;
constexpr size_t WS_PART = 38 * MiB;
constexpr size_t WS_XB = 40 * MiB;
constexpr size_t WS_BIG = 88 * MiB;
constexpr size_t WS_H = WS_BIG;
constexpr size_t WS_P = WS_BIG;
constexpr size_t WS_OBUF = WS_BIG;
constexpr size_t WS_PF = 176 * MiB;
constexpr size_t WS_Y = 192 * MiB;
constexpr size_t WS_KB = 224 * MiB;
constexpr size_t WS_VT = 232 * MiB;
constexpr size_t WS_IKB = 240 * MiB;
constexpr size_t WS_Q = WS_BIG, WS_O = WS_BIG + 32 * MiB;
constexpr size_t WS_END = 242 * MiB;
enum { PL_U = 0, PL_V, PL_B, PL_C, PL_H, PL_Q, PL_IQ, PL_GQ, PL_GK, PL_GV, PL_GG, PL_N };
constexpr int PF_CKV = 0, PF_IK = 128, PF_IW = 192, PF_GA = 196, PF_GB = 200;
constexpr int GR_W = 0, GR_QG = 8192, GR_ATT = 16384, GR_KGT = 24576, GR_U = 32768, GR_BYTES = 49152;
constexpr size_t WS_EG = 512 * 1024;
constexpr size_t WS_WUKV = 64 * 1024;
constexpr int TILE_BYTES = 36864, TR_IK = 0, TR_K = 4096, TR_V = 20480;
constexpr int CW_QCTR = 64;
static_assert((size_t)1024 * GR_BYTES <= (size_t)MTOK * DM * 4, "gdn records fit d_out");
constexpr int LDS_BYTES = 163840;

struct Params {
    const float* in[33];
    float* out; unsigned char* ws;
    int pad0, pad1;
};

struct Frame { LAS unsigned char* lds; unsigned char* ws; int tid, lane, wave, G, bid; };

struct ConvJob { const float* W; const float* W2; const float* gain; bf16_t* dst; int K, Nsrc, Ndst, mode; };
DI int mix_src_col(int n) {
    if (n < 1536) return n;
    if (n < 1792) return n - 1536 + 1664;
    if (n < 2560) return n - 1792 + 1988;
    if (n < 2816) return n - 2560 + 2764;
    if (n < 2944) return n - 2816 + 1536;
    if (n < 3008) return n - 2944 + 1920;
    if (n < 3012) return n - 3008 + 1984;
    if (n < 3016) return n - 3012 + 2756;
    if (n < 3020) return n - 3016 + 2760;
    return -1;
}
template <bool GAIN>
DI void conv_item(const ConvJob& J, LAS unsigned* scr, int item, int lane) {
    const int nblk = J.Ndst / 64, kb = item / nblk, nb = item % nblk, k0 = 64 * kb, n0 = 64 * nb;
    const int n = n0 + lane;
    const float* src = J.W; int col = n;
    if (J.mode == 1) { const int t = n >> 8, j = n & 255; src = (j < 128) ? J.W : J.W2; col = 128 * t + (j & 127); }
    else if (J.mode == 2) { col = mix_src_col(n); }
    const float keep = col >= 0 ? 1.f : 0.f; col = col >= 0 ? col : 0;
    const float* sp = src + (size_t)k0 * J.Nsrc + col;
    float v[64];
#pragma unroll
    for (int kk = 0; kk < 64; ++kk) v[kk] = sp[(size_t)kk * J.Nsrc];
#pragma unroll
    for (int kk = 0; kk < 64; kk += 2) {
        float a0 = v[kk] * keep, a1 = v[kk + 1] * keep;
        if (GAIN) { a0 *= J.gain[k0 + kk]; a1 *= J.gain[k0 + kk + 1]; }
        scr[lane * 33 + (kk >> 1)] = pk2(a0, a1);
    }
    asm volatile("s_waitcnt lgkmcnt(0)" ::: "memory");
    const int c = lane & 7, rg = lane >> 3;
    u32x4 o[8];
#pragma unroll
    for (int j = 0; j < 8; ++j) { const int row = rg + 8 * j; const LAS unsigned* q = scr + row * 33 + 4 * c; o[j].x = q[0]; o[j].y = q[1]; o[j].z = q[2]; o[j].w = q[3]; }
    __builtin_amdgcn_sched_barrier(0);
#pragma unroll
    for (int j = 0; j < 8; ++j) { const int row = rg + 8 * j; *(u32x4*)(J.dst + (size_t)(n0 + row) * J.K + k0 + 8 * c) = o[j]; }
    asm volatile("s_waitcnt lgkmcnt(0)" ::: "memory");
}
DI void conv_run(Frame& F, const ConvJob& J) {
    LAS unsigned* scr = (LAS unsigned*)(F.lds + F.wave * 16384);
    const int gw = F.bid * 8 + F.wave, NGW = F.G * 8, NITEMS = (J.K / 64) * (J.Ndst / 64);
    if (J.gain) { for (int it = gw; it < NITEMS; it += NGW) conv_item<true>(J, scr, it, F.lane); }
    else { for (int it = gw; it < NITEMS; it += NGW) conv_item<false>(J, scr, it, F.lane); }
}
DI bf16_t* slot_of(Frame& F, int id) { return (bf16_t*)(F.ws + ((id & 1) ? WS_SLOTB : WS_SLOTA)); }
DI void conv_for(Frame& F, const Params& p, int layer, int id) {
    ConvJob J; J.W2 = nullptr; J.gain = nullptr; J.dst = slot_of(F, id); J.mode = 0;
    switch (id) {
    case 0: J.W = p.in[4] + (size_t)layer * DM * FF; J.W2 = p.in[5] + (size_t)layer * DM * FF; J.gain = p.in[3] + layer * DM; J.K = DM; J.Nsrc = FF; J.Ndst = 2 * FF; J.mode = 1; break;
    case 1: J.W = p.in[6] + (size_t)layer * FF * DM; J.K = FF; J.Nsrc = DM; J.Ndst = DM; break;
    case 2: J.W = p.in[8] + (size_t)layer * DM * NMIX; J.gain = p.in[7] + layer * DM; J.K = DM; J.Nsrc = NMIX; J.Ndst = NMIXP; J.mode = 2; break;
    case 3: J.W = p.in[9] + (size_t)layer * DM * DM; J.K = DM; J.Nsrc = DM; J.Ndst = DM; break;
    case 4: J.W = p.in[24] + (size_t)layer * DM * DM; J.gain = p.in[22] + layer * DM; J.K = DM; J.Nsrc = DM; J.Ndst = DM; break;
    case 5: J.W = p.in[27] + (size_t)layer * DM * DM; J.K = DM; J.Nsrc = DM; J.Ndst = DM; break;
    case 6: J.W = p.in[29] + (size_t)layer * DM * FF; J.W2 = p.in[30] + (size_t)layer * DM * FF; J.gain = p.in[28] + layer * DM; J.K = DM; J.Nsrc = FF; J.Ndst = 2 * FF; J.mode = 1; break;
    default: J.W = p.in[31] + (size_t)layer * FF * DM; J.K = FF; J.Nsrc = DM; J.Ndst = DM; break;
    }
    conv_run(F, J);
}

DI void prologue(Frame& F, const Params& p) {
    const int gw = F.bid * 8 + F.wave, NGW = F.G * 8, lane = F.lane;
    for (int l = 0; l < DEPTH; ++l) {
        ConvJob J; J.W2 = nullptr; J.gain = nullptr; J.mode = 0; J.K = DM; J.Nsrc = DM; J.Ndst = DM;
        J.W = p.in[25] + (size_t)l * DM * DM; J.dst = (bf16_t*)(F.ws + WS_WKV) + (size_t)(2 * l) * DM * DM; conv_run(F, J);
        J.W = p.in[26] + (size_t)l * DM * DM; J.dst = (bf16_t*)(F.ws + WS_WKV) + (size_t)(2 * l + 1) * DM * DM; conv_run(F, J);
    }
    for (int l = 0; l < DEPTH; ++l) {
        ConvJob J; J.W2 = nullptr; J.gain = p.in[14] + l * 128; J.mode = 0; J.K = 128; J.Nsrc = 256; J.Ndst = 256;
        J.W = p.in[15] + (size_t)l * 128 * 256; J.dst = (bf16_t*)(F.ws + WS_WUKV) + (size_t)(2 * l) * 256 * 128; conv_run(F, J);
        J.W = p.in[16] + (size_t)l * 128 * 256; J.dst = (bf16_t*)(F.ws + WS_WUKV) + (size_t)(2 * l + 1) * 256 * 128; conv_run(F, J);
    }
    conv_for(F, p, 0, 0);
    const float* x = p.in[0]; bf16_t* xb = (bf16_t*)(F.ws + WS_XB); float* part = (float*)(F.ws + WS_PART);
    for (int m0 = gw; m0 < MTOK; m0 += 2 * NGW) {
        f32x4 v[2][4];
#pragma unroll
        for (int k = 0; k < 2; ++k) { const f32x4* xr = (const f32x4*)(x + (size_t)(m0 + k * NGW) * DM) + lane;
#pragma unroll
            for (int j = 0; j < 4; ++j) v[k][j] = xr[64 * j]; }
        asm volatile("" ::: "memory");
#pragma unroll
        for (int k = 0; k < 2; ++k) { const int m = m0 + k * NGW; float s = 0.f;
            u32x2* o = (u32x2*)(xb + (size_t)m * DM) + lane;
#pragma unroll
            for (int j = 0; j < 4; ++j) { const f32x4 vv = v[k][j]; s += (vv[0] * vv[0] + vv[1] * vv[1]) + (vv[2] * vv[2] + vv[3] * vv[3]); u32x2 w; w.x = pk2(vv[0], vv[1]); w.y = pk2(vv[2], vv[3]); o[64 * j] = w; }
            s = wave_sum(s);
            if (lane < 16) part[(size_t)m * 16 + lane] = (lane == 0) ? s : 0.f; }
    }
    const float* mem = p.in[1];
    for (int r = gw; r < DEPTH * MEMROWS; r += NGW) {
        const int l = r / MEMROWS, m = r % MEMROWS;
        const f32x4* xr = (const f32x4*)(mem + (size_t)m * DM) + lane; const f32x4* gr = (const f32x4*)(p.in[23] + l * DM) + lane;
        f32x4 v[4]; float s = 0.f;
#pragma unroll
        for (int j = 0; j < 4; ++j) { v[j] = xr[64 * j]; s += (v[j][0] * v[j][0] + v[j][1] * v[j][1]) + (v[j][2] * v[j][2] + v[j][3] * v[j][3]); }
        const float rstd = rsqrtf(wave_sum(s) * (1.f / DM) + EPS);
        u32x2* o = (u32x2*)((bf16_t*)(F.ws + WS_MEMN) + ((size_t)l * MEMROWS + m) * DM) + lane;
#pragma unroll
        for (int j = 0; j < 4; ++j) { const f32x4 g = gr[64 * j]; u32x2 w; w.x = pk2(v[j][0] * rstd * g[0], v[j][1] * rstd * g[1]); w.y = pk2(v[j][2] * rstd * g[2], v[j][3] * rstd * g[3]); o[64 * j] = w; }
    }
    const int* pos = (const int*)p.in[2]; float* rope = (float*)(F.ws + WS_ROPE);
    for (int i = F.bid * 512 + F.tid; i < MTOK * 8; i += F.G * 512) {
        const int m = i >> 3, k = i & 7;
        const float inv = exp2f(-(float)k * 0.125f * 18.931568569324174f);
        const float ang = (float)pos[m] * inv; double rr = (double)ang; rr -= 6.283185307179586 * rint(rr * 0.15915494309189535);
        const float sn = sinf((float)rr), cs = cosf((float)rr);
        rope[(size_t)m * 16 + k] = cs; rope[(size_t)m * 16 + 8 + k] = sn;
    }
}

DI const bf16_t* plane(Frame& F, int pl) { return (const bf16_t*)(F.ws + WS_P) + (size_t)pl * MTOK * 256; }
DI int crow(int i, int h) { return (i & 3) + 8 * (i >> 2) + 4 * h; }
#define MFMA32(a, b, c) __builtin_amdgcn_mfma_f32_32x32x16_bf16((a), (b), (c), 0, 0, 0)
DI bf16x8 pack8(const f32x16& x, int s) {
    u32x4 p; p.x = pk2(x[8 * s + 0], x[8 * s + 1]); p.y = pk2(x[8 * s + 2], x[8 * s + 3]); p.z = pk2(x[8 * s + 4], x[8 * s + 5]); p.w = pk2(x[8 * s + 6], x[8 * s + 7]);
    return __builtin_bit_cast(bf16x8, p);
}

DI void sg_item(Frame& F, const Params& p, int layer, int c, int hd) {
    LAS bf16_t* Wb = (LAS bf16_t*)F.lds;
    LAS bf16_t* vnT = (LAS bf16_t*)(F.lds + 34816);
    LAS float* rst = (LAS float*)(F.lds + 52224);
    LAS float* outT = (LAS float*)(F.lds + 53248);
    const bf16_t* Pu = plane(F, PL_U); const bf16_t* Pv = plane(F, PL_V);
    bf16_t* Y = (bf16_t*)(F.ws + WS_Y);
    int tid = F.tid; asm volatile("" : "+v"(tid));
    const int t0 = c * 128, lane = tid & 63, wave = F.wave, r = lane & 31, h = lane >> 5;
    const int tq = tid >> 2, qtr = tid & 3;
    {
        const float* Wg = p.in[11] + (size_t)((layer * 4 + hd) * 128) * 128;
        f32x4 wv[8];
#pragma unroll
        for (int k = 0; k < 8; ++k) { const int i = tid + 512 * k; wv[k] = *(const f32x4*)(Wg + (i >> 5) * 128 + (i & 31) * 4); }
#pragma unroll
        for (int k = 0; k < 8; ++k) { const int i = tid + 512 * k, t = i >> 5, s4 = (i & 31) * 4;
            u32x2 o; o.x = pk2(s4 <= t ? wv[k][0] : 0.f, s4 + 1 <= t ? wv[k][1] : 0.f); o.y = pk2(s4 + 2 <= t ? wv[k][2] : 0.f, s4 + 3 <= t ? wv[k][3] : 0.f);
            *(LAS u32x2*)(Wb + t * 136 + s4) = o; }
    }
    {
        const u32x4* src = (const u32x4*)(Pv + (size_t)(t0 + tq) * 256 + qtr * 64); float ss = 0.f;
        u32x4 raw[8];
#pragma unroll
        for (int i = 0; i < 8; ++i) raw[i] = src[i];
#pragma unroll
        for (int i = 0; i < 8; ++i)
#pragma unroll
            for (int e = 0; e < 4; ++e) { const float a = gelu_tanh(bflo(raw[i][e])), bb = gelu_tanh(bfhi(raw[i][e])); ss += a * a + bb * bb; }
        ss += shx<1>(ss); ss += shx<2>(ss);
        const float rs = rsqrtf(ss * (1.f / 256.f) + EPS);
        const u32x4* s2 = (const u32x4*)(Pv + (size_t)(t0 + tq) * 256 + 64 * hd + 16 * qtr); const u32x4 v0 = s2[0], v1 = s2[1];
        const float* gn = p.in[10] + layer * 256 + 64 * hd + 16 * qtr;
#pragma unroll
        for (int e = 0; e < 4; ++e) {
            vnT[(16 * qtr + 2 * e) * 136 + tq] = (bf16_t)(pk2(gelu_tanh(bflo(v0[e])) * rs * gn[2 * e], 0.f) & 0xffffu);
            vnT[(16 * qtr + 2 * e + 1) * 136 + tq] = (bf16_t)(pk2(gelu_tanh(bfhi(v0[e])) * rs * gn[2 * e + 1], 0.f) & 0xffffu);
            vnT[(16 * qtr + 8 + 2 * e) * 136 + tq] = (bf16_t)(pk2(gelu_tanh(bflo(v1[e])) * rs * gn[8 + 2 * e], 0.f) & 0xffffu);
            vnT[(16 * qtr + 8 + 2 * e + 1) * 136 + tq] = (bf16_t)(pk2(gelu_tanh(bfhi(v1[e])) * rs * gn[8 + 2 * e + 1], 0.f) & 0xffffu);
        }
    }
    __syncthreads();
    {
        const int ti = wave >> 1, dj = wave & 1;
        f32x16 acc;
#pragma unroll
        for (int i = 0; i < 16; ++i) acc[i] = 0.f;
        const LAS bf16_t* ap = Wb + (32 * ti + r) * 136 + 8 * h; const LAS bf16_t* bp = vnT + (32 * dj + r) * 136 + 8 * h;
        for (int ks = 0; ks < 2 * (ti + 1); ++ks) acc = MFMA32(*(const LAS bf16x8*)(ap + 16 * ks), *(const LAS bf16x8*)(bp + 16 * ks), acc);
#pragma unroll
        for (int i = 0; i < 16; ++i) outT[(32 * ti + crow(i, h)) * 68 + 32 * dj + r] = acc[i];
    }
    __syncthreads();
    {
        const u32x4* us = (const u32x4*)(Pu + (size_t)(t0 + tq) * 256 + 64 * hd + 16 * qtr); const u32x4 u0 = us[0], u1 = us[1];
        const float bs = p.in[12][(layer * 4 + hd) * 128 + tq];
        const LAS f32x4* mp = (const LAS f32x4*)(outT + tq * 68 + 16 * qtr);
        const f32x4 m0 = mp[0], m1 = mp[1], m2 = mp[2], m3 = mp[3];
        float y[16];
#pragma unroll
        for (int e = 0; e < 4; ++e) { y[2 * e] = gelu_tanh(bflo(u0[e])); y[2 * e + 1] = gelu_tanh(bfhi(u0[e])); y[8 + 2 * e] = gelu_tanh(bflo(u1[e])); y[8 + 2 * e + 1] = gelu_tanh(bfhi(u1[e])); }
#pragma unroll
        for (int e = 0; e < 4; ++e) { y[e] *= m0[e] + bs; y[4 + e] *= m1[e] + bs; y[8 + e] *= m2[e] + bs; y[12 + e] *= m3[e] + bs; }
        u32x4 w0, w1;
        w0.x = pk2(y[0], y[1]); w0.y = pk2(y[2], y[3]); w0.z = pk2(y[4], y[5]); w0.w = pk2(y[6], y[7]);
        w1.x = pk2(y[8], y[9]); w1.y = pk2(y[10], y[11]); w1.z = pk2(y[12], y[13]); w1.w = pk2(y[14], y[15]);
        u32x4* dst = (u32x4*)(Y + (size_t)(t0 + tq) * 1024 + 64 * hd + 16 * qtr);
        dst[0] = w0; dst[1] = w1;
    }
    __syncthreads();
}
DI void sc_item(Frame& F, const Params& p, int layer, int item) {
    const bf16_t* Pb = plane(F, PL_B); const bf16_t* Pc = plane(F, PL_C); const bf16_t* Ph = plane(F, PL_H);
    bf16_t* Y = (bf16_t*)(F.ws + WS_Y);
    const int cgp = F.tid & 31, run = F.tid >> 5, ch0 = 8 * cgp, tr = item * 64 + 4 * run, bstart = (tr / SEQ) * SEQ;
    const f32x4* wp = (const f32x4*)(p.in[13] + (size_t)layer * 256 * 3 + ch0 * 3);
    float wf[24];
#pragma unroll
    for (int k = 0; k < 6; ++k) { const f32x4 t4 = wp[k]; wf[4 * k] = t4[0]; wf[4 * k + 1] = t4[1]; wf[4 * k + 2] = t4[2]; wf[4 * k + 3] = t4[3]; }
    u32x4 c8[6], h8[6], b8[4];
#pragma unroll
    for (int k = 0; k < 6; ++k) { const int tok = tr - 2 + k; const int tc = tok >= bstart ? tok : bstart;
        c8[k] = *(const u32x4*)(Pc + (size_t)tc * 256 + ch0); h8[k] = *(const u32x4*)(Ph + (size_t)tc * 256 + ch0); }
#pragma unroll
    for (int t = 0; t < 4; ++t) b8[t] = *(const u32x4*)(Pb + (size_t)(tr + t) * 256 + ch0);
    float x[6][8];
#pragma unroll
    for (int k = 0; k < 6; ++k) { const float keep = (tr - 2 + k) >= bstart ? 1.f : 0.f;
#pragma unroll
        for (int e = 0; e < 4; ++e) { x[k][2 * e] = bflo(c8[k][e]) * bflo(h8[k][e]) * keep; x[k][2 * e + 1] = bfhi(c8[k][e]) * bfhi(h8[k][e]) * keep; } }
#pragma unroll
    for (int t = 0; t < 4; ++t) {
        float y[8];
#pragma unroll
        for (int e = 0; e < 8; ++e) { const float bb = (e & 1) ? bfhi(b8[t][e >> 1]) : bflo(b8[t][e >> 1]);
            y[e] = bb * (wf[3 * e] * x[t][e] + wf[3 * e + 1] * x[t + 1][e] + wf[3 * e + 2] * x[t + 2][e]); }
        u32x4 w; w.x = pk2(y[0], y[1]); w.y = pk2(y[2], y[3]); w.z = pk2(y[4], y[5]); w.w = pk2(y[6], y[7]);
        *(u32x4*)(Y + (size_t)(tr + t) * 1024 + 256 + ch0) = w;
    }
}
DI void dsa_prep_item(Frame& F, const Params& p, int layer, int item) {
    LAS bf16_t* cs = (LAS bf16_t*)F.lds;
    const float* Pf = (const float*)(F.ws + WS_PF); const float* rope = (const float*)(F.ws + WS_ROPE);
    const int t0 = item * 64, tid = F.tid, lane = F.lane, wave = F.wave, r = lane & 31, h = lane >> 5;
    unsigned char* rec0 = F.ws + WS_KB + (size_t)(2 * item) * TILE_BYTES;
    {
        const int t = tid >> 3, seg = tid & 7;
        const f32x4* src = (const f32x4*)(Pf + (size_t)(t0 + t) * 256 + PF_CKV + seg * 16);
        f32x4 v[4]; float s = 0.f;
#pragma unroll
        for (int i = 0; i < 4; ++i) { v[i] = src[i]; s += (v[i][0] * v[i][0] + v[i][1] * v[i][1]) + (v[i][2] * v[i][2] + v[i][3] * v[i][3]); }
        s += shx<1>(s); s += shx<2>(s); s += shx<4>(s);
        const float rr = rsqrtf(s * (1.f / 128.f) + EPS);
        u32x4 c0, c1;
        c0.x = pk2(v[0][0] * rr, v[0][1] * rr); c0.y = pk2(v[0][2] * rr, v[0][3] * rr); c0.z = pk2(v[1][0] * rr, v[1][1] * rr); c0.w = pk2(v[1][2] * rr, v[1][3] * rr);
        c1.x = pk2(v[2][0] * rr, v[2][1] * rr); c1.y = pk2(v[2][2] * rr, v[2][3] * rr); c1.z = pk2(v[3][0] * rr, v[3][1] * rr); c1.w = pk2(v[3][2] * rr, v[3][3] * rr);
        *(LAS u32x4*)(cs + t * 136 + seg * 16) = c0; *(LAS u32x4*)(cs + t * 136 + seg * 16 + 8) = c1;
        const f32x4* s2 = (const f32x4*)(Pf + (size_t)(t0 + t) * 256 + PF_IK + seg * 8);
        const f32x4 a0 = s2[0], a1 = s2[1];
        float q = (a0[0] * a0[0] + a0[1] * a0[1]) + (a0[2] * a0[2] + a0[3] * a0[3]) + (a1[0] * a1[0] + a1[1] * a1[1]) + (a1[2] * a1[2] + a1[3] * a1[3]);
        q += shx<1>(q); q += shx<2>(q); q += shx<4>(q);
        const float r2 = rsqrtf(q * (1.f / 64.f) + EPS); const float* g2 = p.in[17] + layer * 64 + seg * 8;
        float x[8];
#pragma unroll
        for (int e = 0; e < 4; ++e) { x[e] = a0[e] * r2 * g2[e]; x[4 + e] = a1[e] * r2 * g2[4 + e]; }
        const float* rp = rope + (size_t)(t0 + t) * 16;
#pragma unroll
        for (int e = 0; e < 8; ++e) { const float o = shx<1>(x[e]); const float cv = rp[e], sv = rp[8 + e];
            if (seg == 0) x[e] = x[e] * cv - o * sv; else if (seg == 1) x[e] = x[e] * cv + o * sv; }
        u32x4 w; w.x = pk2(x[0], x[1]); w.y = pk2(x[2], x[3]); w.z = pk2(x[4], x[5]); w.w = pk2(x[6], x[7]);
        *(u32x4*)(rec0 + (size_t)(t >> 5) * TILE_BYTES + TR_IK + (((seg >> 1) * 64) + (seg & 1) * 32 + (t & 31)) * 16) = w;
    }
    __syncthreads();
    const bf16_t* WukT = (const bf16_t*)(F.ws + WS_WUKV) + (size_t)(2 * layer) * 256 * 128; const bf16_t* WuvT = WukT + 256 * 128;
    f32x16 KT[2], VV[2];
#pragma unroll
    for (int tt = 0; tt < 2; ++tt)
#pragma unroll
        for (int i = 0; i < 16; ++i) { KT[tt][i] = 0.f; VV[tt][i] = 0.f; }
    bf16x8 wkf[8], wvf[8];
#pragma unroll
    for (int k8 = 0; k8 < 8; ++k8) { wkf[k8] = *(const bf16x8*)(WukT + (size_t)(32 * wave + r) * 128 + 16 * k8 + 8 * h); wvf[k8] = *(const bf16x8*)(WuvT + (size_t)(32 * wave + r) * 128 + 16 * k8 + 8 * h); }
    __builtin_amdgcn_sched_barrier(0);
#pragma unroll
    for (int k8 = 0; k8 < 8; ++k8) {
#pragma unroll
        for (int tt = 0; tt < 2; ++tt) {
            const bf16x8 cf = *(const LAS bf16x8*)(cs + (32 * tt + r) * 136 + 16 * k8 + 8 * h);
            KT[tt] = MFMA32(wkf[k8], cf, KT[tt]);
            VV[tt] = MFMA32(cf, wvf[k8], VV[tt]);
        }
    }
    const int hd = wave >> 1, half = wave & 1;
#pragma unroll
    for (int tt = 0; tt < 2; ++tt) {
        unsigned char* rec = rec0 + (size_t)tt * TILE_BYTES;
        if (half == 0) {
            const float* rp = rope + (size_t)(t0 + 32 * tt + r) * 16 + 4 * h;
#pragma unroll
            for (int i = 0; i < 4; ++i) { const float cv = rp[i], sv = rp[8 + i], x1 = KT[tt][i], x2 = KT[tt][i + 4]; KT[tt][i] = x1 * cv - x2 * sv; KT[tt][i + 4] = x2 * cv + x1 * sv; }
        }
#pragma unroll
        for (int s = 0; s < 2; ++s) {
            *(bf16x8*)(rec + TR_K + ((hd * 4 + 2 * half + s) * 64 + lane) * 16) = pack8(KT[tt], s);
            *(bf16x8*)(rec + TR_V + (((hd * 2 + half) * 2 + s) * 64 + lane) * 16) = pack8(VV[tt], s);
        }
    }
    __syncthreads();
}
template <int I> struct SolveRow {
    template <class X> static DI void run(const LAS float* As, X& x, const float (&rhs)[64]) {
        SolveRow<I - 1>::run(As, x, rhs);
        float a4[4] = {rhs[I], 0.f, 0.f, 0.f};
#pragma unroll
        for (int j4 = 0; j4 < (I + 3) / 4; ++j4) { const f32x4 c = *(const LAS f32x4*)(As + I * 68 + 4 * j4);
#pragma unroll
            for (int e = 0; e < 4; ++e) if (4 * j4 + e < I) a4[e] = __builtin_fmaf(c[e], -x[4 * j4 + e], a4[e]); }
        x[I] = (a4[0] + a4[1]) + (a4[2] + a4[3]);
    }
};
template <> struct SolveRow<-1> { template <class X> static DI void run(const LAS float*, X&, const float (&)[64]) {} };

#ifndef PROBE_GDN
#define PROBE_GDN 0
#endif
DI int probe_reps(int which) { int r_ = (PROBE_GDN == which) ? 3 : 1; if (PROBE_GDN) asm volatile("" : "+s"(r_)); return r_; }
DI void gdn_prep_item(Frame& F, const Params& p, int layer, int rec) {
    const int b = rec >> 9, hd = (rec >> 7) & 3, n = rec & 127, t0 = b * SEQ + 64 * n, bstart = b * SEQ, tid = F.tid, lane = F.lane;
    LAS unsigned char* L = F.lds; asm volatile("" : "+s"(L));
    LAS float* qs = (LAS float*)L; LAS float* ks = qs + 64 * 65; LAS float* vs = ks + 64 * 65;
    LAS float* As = (LAS float*)(L + 49920);
    LAS float* gcs = (LAS float*)(L + 67328); LAS float* bts = gcs + 64; LAS float* egc = bts + 64;
    LAS float* Xs = (LAS float*)(L + 68096);
    LAS float* Ts = (LAS float*)(L + 101120);
    const float* Pf = (const float*)(F.ws + WS_PF);
#pragma unroll
    for (int k = 0; k < 3; ++k) {
        const int part = k, rem = tid, t = rem >> 3, seg = rem & 7, ch = part * 256 + 64 * hd + 8 * seg;
        const bf16_t* pl = plane(F, PL_GQ + part) + 64 * hd + 8 * seg; const f32x4* w = (const f32x4*)(p.in[18] + ((size_t)layer * 768 + ch) * 4);
        float acc[8];
#pragma unroll
        for (int e = 0; e < 8; ++e) acc[e] = 0.f;
        f32x4 wv[8];
#pragma unroll
        for (int e = 0; e < 8; ++e) wv[e] = w[e];
#pragma unroll
        for (int j = 0; j < 4; ++j) { const int tt = t0 + t - 3 + j; const int tc = tt >= bstart ? tt : bstart; const float keep = tt >= bstart ? 1.f : 0.f;
            const u32x4 raw = *(const u32x4*)(pl + (size_t)tc * 256);
#pragma unroll
            for (int e = 0; e < 4; ++e) { acc[2 * e] = __builtin_fmaf(wv[2 * e][j] * keep, bflo(raw[e]), acc[2 * e]); acc[2 * e + 1] = __builtin_fmaf(wv[2 * e + 1][j] * keep, bfhi(raw[e]), acc[2 * e + 1]); } }
#pragma unroll
        for (int e = 0; e < 8; ++e) qs[part * 4160 + t * 65 + 8 * seg + e] = silu_f(acc[e]);
    }
    __syncthreads();
    {
        const int t = tid >> 3, seg = tid & 7; float sq = 0.f, sk = 0.f;
        float qa[8], ka[8];
#pragma unroll
        for (int e = 0; e < 8; ++e) { qa[e] = qs[t * 65 + seg * 8 + e]; ka[e] = ks[t * 65 + seg * 8 + e]; }
        __builtin_amdgcn_sched_barrier(0);
#pragma unroll
        for (int e = 0; e < 8; ++e) { sq += qa[e] * qa[e]; sk += ka[e] * ka[e]; }
        sq += shx<1>(sq); sq += shx<2>(sq); sq += shx<4>(sq);
        sk += shx<1>(sk); sk += shx<2>(sk); sk += shx<4>(sk);
        const float rq = rsqrtf(sq + EPS) * 0.125f, rk = rsqrtf(sk + EPS);
#pragma unroll
        for (int e = 0; e < 8; ++e) { qs[t * 65 + seg * 8 + e] = qa[e] * rq; ks[t * 65 + seg * 8 + e] = ka[e] * rk; }
        if (tid < 64) {
            const float a = Pf[(size_t)(t0 + tid) * 256 + PF_GA + hd], bb = Pf[(size_t)(t0 + tid) * 256 + PF_GB + hd];
            const float xx = a + p.in[20][layer * 4 + hd]; const float ee = expf(-fabsf(xx)); const float l1p = (ee < 1e-2f) ? ee * (1.f - ee * (0.5f - ee * 0.33333333f)) : logf(1.f + ee); const float sp = fmaxf(xx, 0.f) + l1p;
            const float g = -expf(p.in[19][layer * 4 + hd]) * sp;
            bts[tid] = 1.f / (1.f + expf(-bb));
            gcs[tid] = g;
        }
    }
    __syncthreads();
    float run_ = 0.f;
    if (tid < 64) {
#pragma unroll
        for (int b4 = 0; b4 < 4; ++b4) {
            const LAS f32x4* gp = (const LAS f32x4*)(gcs + 16 * b4); const f32x4 g0 = gp[0], g1 = gp[1], g2 = gp[2], g3 = gp[3];
            __builtin_amdgcn_sched_barrier(0);
#pragma unroll
            for (int i = 0; i < 16; ++i) { const float gi = (i >> 2) == 0 ? g0[i & 3] : (i >> 2) == 1 ? g1[i & 3] : (i >> 2) == 2 ? g2[i & 3] : g3[i & 3]; run_ += (16 * b4 + i <= tid) ? gi : 0.f; }
            __builtin_amdgcn_sched_barrier(0);
        }
    }
    __syncthreads();
    if (tid < 64) { gcs[tid] = run_; egc[tid] = expf(run_); }
    __syncthreads();
    {
        const int wv_ = F.wave, m = wv_ >> 2, ti = (wv_ >> 1) & 1, tj = wv_ & 1, r = lane & 31, h = lane >> 5;
        f32x16 acc;
#pragma unroll
        for (int i = 0; i < 16; ++i) acc[i] = 0.f;
        if (ti >= tj) {
            const LAS float* ap = (m ? qs : ks) + (32 * ti + r) * 65 + h; const LAS float* bp = ks + (32 * tj + r) * 65 + h;
#pragma unroll 8
            for (int s2 = 0; s2 < 32; ++s2) acc = __builtin_amdgcn_mfma_f32_32x32x2f32(ap[2 * s2], bp[2 * s2], acc, 0, 0, 0);
        }
        const int j = 32 * tj + r; const float gj = gcs[j];
        float gi_[16], bi_[16];
#pragma unroll
        for (int i2 = 0; i2 < 16; ++i2) { const int i = 32 * ti + crow(i2, h); gi_[i2] = gcs[i]; bi_[i2] = bts[i]; }
        __builtin_amdgcn_sched_barrier(0);
        LAS float* const dstm = m ? Ts : As; const int ldm = m ? 65 : 68;
#pragma unroll
        for (int i2 = 0; i2 < 16; ++i2) { const int i = 32 * ti + crow(i2, h); const float dec = (i >= j) ? __expf(gi_[i2] - gj) : 0.f;
            const float va_ = (i > j) ? bi_[i2] * acc[i2] * dec : 0.f, vt_ = acc[i2] * dec;
            dstm[i * ldm + j] = m ? vt_ : va_; }
    }
    __syncthreads();
    {
        float xv[16];
        const int c_ = tid & 127; const bool isv_ = c_ < 64;
        const LAS float* const srcx = isv_ ? vs + c_ : ks + (c_ - 64);
        float sv_[16], sb_[16], se_[16];
#pragma unroll
        for (int k = 0; k < 16; ++k) { const int row = (tid >> 7) + 4 * k; sv_[k] = srcx[row * 65]; sb_[k] = bts[row]; se_[k] = egc[row]; }
        __builtin_amdgcn_sched_barrier(0);
#pragma unroll
        for (int k = 0; k < 16; ++k) xv[k] = isv_ ? sv_[k] * sb_[k] : sv_[k] * sb_[k] * se_[k];
        __builtin_amdgcn_sched_barrier(0);
#pragma unroll
        for (int k = 0; k < 16; ++k) { const int i = tid + 512 * k, row = i >> 7, c = i & 127; Xs[row * 129 + c] = xv[k]; }
    }
    __syncthreads();
    {
        const int wv_ = F.wave, c0 = 16 * wv_, n = lane & 15, qd = lane >> 4;
        typedef float f32x4v __attribute__((ext_vector_type(4)));
#pragma unroll
        for (int bb = 0; bb < 4; ++bb) {
            if (bb > 0) {
                f32x4v acc;
#pragma unroll
                for (int e = 0; e < 4; ++e) acc[e] = Xs[(16 * bb + 4 * qd + e) * 129 + c0 + n];
                float av_[12], bv_[12];
#pragma unroll
                for (int cb = 0; cb < bb; ++cb)
#pragma unroll
                    for (int s4 = 0; s4 < 4; ++s4) {
                        av_[4 * cb + s4] = As[(16 * bb + n) * 68 + 16 * cb + 4 * s4 + qd];
                        bv_[4 * cb + s4] = Xs[(16 * cb + 4 * s4 + qd) * 129 + c0 + n];
                    }
                __builtin_amdgcn_sched_barrier(0);
#pragma unroll
                for (int cb = 0; cb < bb; ++cb)
#pragma unroll
                    for (int s4 = 0; s4 < 4; ++s4) acc = __builtin_amdgcn_mfma_f32_16x16x4f32(-av_[4 * cb + s4], bv_[4 * cb + s4], acc, 0, 0, 0);
#pragma unroll
                for (int e = 0; e < 4; ++e) Xs[(16 * bb + 4 * qd + e) * 129 + c0 + n] = acc[e];
            }
            if (lane < 16) {
                float x[16], r0[16];
#pragma unroll
                for (int i = 0; i < 16; ++i) r0[i] = Xs[(16 * bb + i) * 129 + c0 + lane];
#pragma unroll
                for (int i4 = 0; i4 < 4; ++i4) {
                    f32x4 cc[4][4];
#pragma unroll
                    for (int ii = 0; ii < 4; ++ii)
#pragma unroll
                        for (int j4 = 0; j4 <= i4; ++j4) cc[ii][j4] = *(const LAS f32x4*)(As + (16 * bb + 4 * i4 + ii) * 68 + 16 * bb + 4 * j4);
                    __builtin_amdgcn_sched_barrier(0);
#pragma unroll
                    for (int ii = 0; ii < 4; ++ii) { const int i = 4 * i4 + ii;
                        float a4[4] = {r0[i], 0.f, 0.f, 0.f};
#pragma unroll
                        for (int j4 = 0; j4 <= i4; ++j4)
#pragma unroll
                            for (int e = 0; e < 4; ++e) if (4 * j4 + e < i) a4[e] = __builtin_fmaf(cc[ii][j4][e], -x[4 * j4 + e], a4[e]);
                        x[i] = (a4[0] + a4[1]) + (a4[2] + a4[3]);
                    }
                }
#pragma unroll
                for (int i = 0; i < 16; ++i) Xs[(16 * bb + i) * 129 + c0 + lane] = x[i];
            }
        }
    }
    __syncthreads();
    {
        unsigned char* recp = (unsigned char*)p.out + (size_t)rec * GR_BYTES;
        const int f = tid >> 6, rt = f >> 2, s4 = f & 3, r = lane & 31, h = lane >> 5, row = 32 * rt + r;
        const float gl = gcs[63];
        float vw[8], vq[8], va[8], vk[8];
#pragma unroll
        for (int j = 0; j < 8; ++j) { const int kidx = 16 * s4 + 8 * (j >> 2) + 4 * h + (j & 3);
            vw[j] = Xs[row * 129 + 64 + kidx]; vq[j] = qs[row * 65 + kidx] * egc[row]; va[j] = Ts[row * 65 + kidx]; vk[j] = ks[kidx * 65 + row] * __expf(gl - gcs[kidx]); }
        u32x4 w;
        w.x = pk2(vw[0], vw[1]); w.y = pk2(vw[2], vw[3]); w.z = pk2(vw[4], vw[5]); w.w = pk2(vw[6], vw[7]); *(u32x4*)(recp + GR_W + (f * 64 + lane) * 16) = w;
        w.x = pk2(vq[0], vq[1]); w.y = pk2(vq[2], vq[3]); w.z = pk2(vq[4], vq[5]); w.w = pk2(vq[6], vq[7]); *(u32x4*)(recp + GR_QG + (f * 64 + lane) * 16) = w;
        w.x = pk2(va[0], va[1]); w.y = pk2(va[2], va[3]); w.z = pk2(va[4], va[5]); w.w = pk2(va[6], va[7]); *(u32x4*)(recp + GR_ATT + (f * 64 + lane) * 16) = w;
        w.x = pk2(vk[0], vk[1]); w.y = pk2(vk[2], vk[3]); w.z = pk2(vk[4], vk[5]); w.w = pk2(vk[6], vk[7]); *(u32x4*)(recp + GR_KGT + (f * 64 + lane) * 16) = w;
        const int vt = f >> 2, ct = (f >> 1) & 1, i0 = 8 * (f & 1);
        f32x4 u0, u1;
#pragma unroll
        for (int e = 0; e < 4; ++e) { u0[e] = Xs[(32 * ct + crow(i0 + e, h)) * 129 + 32 * vt + r]; u1[e] = Xs[(32 * ct + crow(i0 + 4 + e, h)) * 129 + 32 * vt + r]; }
        float* up = (float*)(recp + GR_U) + ((vt * 2 + ct) * 64 + lane) * 16 + i0;
        *(f32x4*)up = u0; *(f32x4*)(up + 4) = u1;
        if (tid == 0) ((float*)(F.ws + WS_EG))[rec] = expf(gl);
    }
    __syncthreads();
}
#ifndef PROBE_PREP
#define PROBE_PREP 0
#endif
DI void phase_prep(Frame& F, const Params& p, int layer) {
    for (int it = F.bid; it < 2048; it += F.G) {
        int reps = 1;
        if (PROBE_PREP) { const int ty = it < 1024 ? 1 : it < 1536 ? 2 : it < 1792 ? 3 : 4; reps = (ty == PROBE_PREP) ? 3 : 1; asm volatile("" : "+s"(reps)); }
#pragma unroll 1
        for (int rp = 0; rp < reps; ++rp) {
            int it2 = it; if (PROBE_PREP) asm volatile("" : "+s"(it2));
            if (it2 < 1024) gdn_prep_item(F, p, layer, it2);
            else if (it2 < 1536) sg_item(F, p, layer, (it2 - 1024) >> 2, (it2 - 1024) & 3);
            else if (it2 < 1792) dsa_prep_item(F, p, layer, it2 - 1536);
            else sc_item(F, p, layer, it2 - 1792);
        }
    }
}

DI void gdn_scan(Frame& F, const Params& p, int layer, int bh) {
    const int b = bh >> 2, hd = bh & 3, tid = F.tid, lane = F.lane, wave = F.wave, r = lane & 31, h = lane >> 5;
    const unsigned char* rec0 = (unsigned char*)p.out + (size_t)(bh * 128) * GR_BYTES;
    const float* EG = (const float*)(F.ws + WS_EG) + bh * 128;
    float* obuf = (float*)(F.ws + WS_OBUF);
    LAS unsigned char* lds = F.lds;
    LAS float* egs = (LAS float*)(lds + 2 * GR_BYTES);
    for (int i = tid; i < GR_BYTES / 16; i += 512) *(LAS u32x4*)(lds + i * 16) = *(const u32x4*)(rec0 + i * 16);
    if (tid == 0) egs[0] = EG[0];
    __syncthreads();
    f32x16 S0, S1;
#pragma unroll
    for (int i = 0; i < 16; ++i) { S0[i] = 0.f; S1[i] = 0.f; }
    u32x4 pv[8]; float pe = 0.f;
    if (wave >= 2) {
        const unsigned char* src = rec0 + (size_t)1 * GR_BYTES;
#pragma unroll
        for (int k = 0; k < 8; ++k) pv[k] = *(const u32x4*)(src + ((tid - 128) + 384 * k) * 16);
        if (tid == 128) pe = EG[1];
    }
    for (int n = 0; n < 128; ++n) {
        LAS unsigned char* st = lds + (n & 1) * GR_BYTES;
        if (wave >= 2) {
            if (n + 1 < 128) {
                LAS unsigned char* dst = lds + ((n + 1) & 1) * GR_BYTES;
#pragma unroll
                for (int k = 0; k < 8; ++k) *(LAS u32x4*)(dst + ((tid - 128) + 384 * k) * 16) = pv[k];
                if (tid == 128) egs[(n + 1) & 1] = pe;
            }
            if (n + 2 < 128) {
                const unsigned char* src = rec0 + (size_t)(n + 2) * GR_BYTES;
#pragma unroll
                for (int k = 0; k < 8; ++k) pv[k] = *(const u32x4*)(src + ((tid - 128) + 384 * k) * 16);
                if (tid == 128) pe = EG[n + 2];
            }
        } else {
            const int vt = wave;
            const float eg = egs[n & 1];
#define GFRAG(off, f) (*(const LAS bf16x8*)(st + (off) + ((f) * 64 + lane) * 16))
            const bf16x8 sb0 = pack8(S0, 0), sb1 = pack8(S0, 1), sb2 = pack8(S1, 0), sb3 = pack8(S1, 1);
            f32x16 ws0, ws1, o0, o1;
#pragma unroll
            for (int i = 0; i < 16; ++i) { ws0[i] = 0.f; ws1[i] = 0.f; o0[i] = 0.f; o1[i] = 0.f; }
            ws0 = MFMA32(GFRAG(GR_W, 0), sb0, ws0); ws0 = MFMA32(GFRAG(GR_W, 1), sb1, ws0); ws0 = MFMA32(GFRAG(GR_W, 2), sb2, ws0); ws0 = MFMA32(GFRAG(GR_W, 3), sb3, ws0);
            ws1 = MFMA32(GFRAG(GR_W, 4), sb0, ws1); ws1 = MFMA32(GFRAG(GR_W, 5), sb1, ws1); ws1 = MFMA32(GFRAG(GR_W, 6), sb2, ws1); ws1 = MFMA32(GFRAG(GR_W, 7), sb3, ws1);
            o0 = MFMA32(GFRAG(GR_QG, 0), sb0, o0); o0 = MFMA32(GFRAG(GR_QG, 1), sb1, o0); o0 = MFMA32(GFRAG(GR_QG, 2), sb2, o0); o0 = MFMA32(GFRAG(GR_QG, 3), sb3, o0);
            o1 = MFMA32(GFRAG(GR_QG, 4), sb0, o1); o1 = MFMA32(GFRAG(GR_QG, 5), sb1, o1); o1 = MFMA32(GFRAG(GR_QG, 6), sb2, o1); o1 = MFMA32(GFRAG(GR_QG, 7), sb3, o1);
            const f32x16 u0 = *(const LAS f32x16*)(st + GR_U + ((vt * 2 + 0) * 64 + lane) * 64), u1 = *(const LAS f32x16*)(st + GR_U + ((vt * 2 + 1) * 64 + lane) * 64);
            const f32x16 vn0 = u0 - ws0, vn1 = u1 - ws1;
            const bf16x8 vb0 = pack8(vn0, 0), vb1 = pack8(vn0, 1), vb2 = pack8(vn1, 0), vb3 = pack8(vn1, 1);
            o0 = MFMA32(GFRAG(GR_ATT, 0), vb0, o0); o0 = MFMA32(GFRAG(GR_ATT, 1), vb1, o0); o0 = MFMA32(GFRAG(GR_ATT, 2), vb2, o0); o0 = MFMA32(GFRAG(GR_ATT, 3), vb3, o0);
            o1 = MFMA32(GFRAG(GR_ATT, 4), vb0, o1); o1 = MFMA32(GFRAG(GR_ATT, 5), vb1, o1); o1 = MFMA32(GFRAG(GR_ATT, 6), vb2, o1); o1 = MFMA32(GFRAG(GR_ATT, 7), vb3, o1);
            S0 = S0 * eg; S1 = S1 * eg;
            S0 = MFMA32(GFRAG(GR_KGT, 0), vb0, S0); S0 = MFMA32(GFRAG(GR_KGT, 1), vb1, S0); S0 = MFMA32(GFRAG(GR_KGT, 2), vb2, S0); S0 = MFMA32(GFRAG(GR_KGT, 3), vb3, S0);
            S1 = MFMA32(GFRAG(GR_KGT, 4), vb0, S1); S1 = MFMA32(GFRAG(GR_KGT, 5), vb1, S1); S1 = MFMA32(GFRAG(GR_KGT, 6), vb2, S1); S1 = MFMA32(GFRAG(GR_KGT, 7), vb3, S1);
#undef GFRAG
            float* ob = obuf + (size_t)(b * SEQ + 64 * n) * 256 + 64 * hd + 32 * vt + r;
#pragma unroll
            for (int i = 0; i < 16; ++i) { ob[(size_t)crow(i, h) * 256] = o0[i]; ob[(size_t)(32 + crow(i, h)) * 256] = o1[i]; }
        }
        __syncthreads();
    }
    __syncthreads();
}
DI void gdn_finalize_bh(Frame& F, const Params& p, int layer, int bh);
DI void gdn_finalize(Frame& F, const Params& p, int layer) {
    const float* obuf = (const float*)(F.ws + WS_OBUF); const bf16_t* Pg = plane(F, PL_GG); bf16_t* Y = (bf16_t*)(F.ws + WS_Y);
    const float* gnp = p.in[21] + layer * 64;
    for (int i = F.bid * 512 + F.tid; i < MTOK * 16; i += F.G * 512) {
        const int tok = i >> 4, hd = (i >> 2) & 3, qd = i & 3;
        const f32x4* src = (const f32x4*)(obuf + (size_t)tok * 256 + 64 * hd + 16 * qd);
        f32x4 o[4]; float ss = 0.f;
#pragma unroll
        for (int k = 0; k < 4; ++k) { o[k] = src[k]; ss += (o[k][0] * o[k][0] + o[k][1] * o[k][1]) + (o[k][2] * o[k][2] + o[k][3] * o[k][3]); }
        ss += shx<1>(ss); ss += shx<2>(ss);
        const float rr = rsqrtf(ss * (1.f / 64.f) + EPS);
        const u32x4* gsrc = (const u32x4*)(Pg + (size_t)tok * 256 + 64 * hd + 16 * qd);
        const u32x4 g0 = gsrc[0], g1 = gsrc[1];
        float gt[16];
#pragma unroll
        for (int e = 0; e < 4; ++e) { gt[2 * e] = bflo(g0[e]); gt[2 * e + 1] = bfhi(g0[e]); gt[8 + 2 * e] = bflo(g1[e]); gt[8 + 2 * e + 1] = bfhi(g1[e]); }
        float y[16];
#pragma unroll
        for (int k = 0; k < 4; ++k) { const f32x4 gn = *(const f32x4*)(gnp + 16 * qd + 4 * k);
#pragma unroll
            for (int e = 0; e < 4; ++e) y[4 * k + e] = o[k][e] * rr * gn[e] * silu_f(gt[4 * k + e]); }
        u32x4 w0, w1;
        w0.x = pk2(y[0], y[1]); w0.y = pk2(y[2], y[3]); w0.z = pk2(y[4], y[5]); w0.w = pk2(y[6], y[7]);
        w1.x = pk2(y[8], y[9]); w1.y = pk2(y[10], y[11]); w1.z = pk2(y[12], y[13]); w1.w = pk2(y[14], y[15]);
        u32x4* dst = (u32x4*)(Y + (size_t)tok * 1024 + 768 + 64 * hd + 16 * qd);
        dst[0] = w0; dst[1] = w1;
    }
}

DI void gdn_finalize_bh(Frame& F, const Params& p, int layer, int bh) {
    const int b = bh >> 2, hd = bh & 3;
    const float* obuf = (const float*)(F.ws + WS_OBUF); const bf16_t* Pg = plane(F, PL_GG); bf16_t* Y = (bf16_t*)(F.ws + WS_Y);
    const float* gnp = p.in[21] + layer * 64;
    for (int i0 = F.tid; i0 < SEQ * 4; i0 += 4 * 512) {
        f32x4 o[4][4]; u32x4 g0[4], g1[4];
#pragma unroll
        for (int k4 = 0; k4 < 4; ++k4) { const int i = i0 + 512 * k4, tok = b * SEQ + (i >> 2), qd = i & 3;
            const f32x4* src = (const f32x4*)(obuf + (size_t)tok * 256 + 64 * hd + 16 * qd);
#pragma unroll
            for (int k = 0; k < 4; ++k) o[k4][k] = src[k];
            const u32x4* gsrc = (const u32x4*)(Pg + (size_t)tok * 256 + 64 * hd + 16 * qd); g0[k4] = gsrc[0]; g1[k4] = gsrc[1]; }
        asm volatile("" ::: "memory");
#pragma unroll
        for (int k4 = 0; k4 < 4; ++k4) { const int i = i0 + 512 * k4, tok = b * SEQ + (i >> 2), qd = i & 3;
            float ss = 0.f;
#pragma unroll
            for (int k = 0; k < 4; ++k) ss += (o[k4][k][0] * o[k4][k][0] + o[k4][k][1] * o[k4][k][1]) + (o[k4][k][2] * o[k4][k][2] + o[k4][k][3] * o[k4][k][3]);
            ss += shx<1>(ss); ss += shx<2>(ss);
            const float rr = rsqrtf(ss * (1.f / 64.f) + EPS);
            float gt[16];
#pragma unroll
            for (int e = 0; e < 4; ++e) { gt[2 * e] = bflo(g0[k4][e]); gt[2 * e + 1] = bfhi(g0[k4][e]); gt[8 + 2 * e] = bflo(g1[k4][e]); gt[8 + 2 * e + 1] = bfhi(g1[k4][e]); }
            float y[16];
#pragma unroll
            for (int k = 0; k < 4; ++k) { const f32x4 gn = *(const f32x4*)(gnp + 16 * qd + 4 * k);
#pragma unroll
                for (int e = 0; e < 4; ++e) y[4 * k + e] = o[k4][k][e] * rr * gn[e] * silu_f(gt[4 * k + e]); }
            u32x4 w0, w1;
            w0.x = pk2(y[0], y[1]); w0.y = pk2(y[2], y[3]); w0.z = pk2(y[4], y[5]); w0.w = pk2(y[6], y[7]);
            w1.x = pk2(y[8], y[9]); w1.y = pk2(y[10], y[11]); w1.z = pk2(y[12], y[13]); w1.w = pk2(y[14], y[15]);
            u32x4* dst = (u32x4*)(Y + (size_t)tok * 1024 + 768 + 64 * hd + 16 * qd);
            dst[0] = w0; dst[1] = w1; }
    }
}

DI unsigned f2key(float s) { const unsigned u = __float_as_uint(s); const int m = (int)u >> 31; return u ^ ((unsigned)m | 0x80000000u); }
DI float relu_f(float x) { return __builtin_amdgcn_fmed3f(x, 0.f, 3.0e38f); }
DI float max_f(float a, float b) { return __builtin_amdgcn_fmed3f(a, b, 3.0e38f); }
DI int hidx(int q, int word) { return word * 32 + q; }
constexpr int DSA_IQF = 131072;
constexpr int DSA_MISC = 147456;

DI bf16x8 ld16(const void* base, unsigned byteoff) { return *(const bf16x8*)((const unsigned char*)base + byteoff); }
DI void dsa_load_ik(const unsigned char* recs, int tile, int lane, bf16x8 (&a)[4]) {
    const unsigned off = (unsigned)tile * (unsigned)TILE_BYTES + TR_IK + 16u * lane;
#pragma unroll
    for (int ks = 0; ks < 4; ++ks) a[ks] = ld16(recs, off + 1024u * ks);
}
DI void dsa_tile_scores(const bf16x8 (&a)[4], const bf16x8 (&Biq)[4][4], const float (&w)[4], f32x16& sc) {
#pragma unroll
    for (int hd = 0; hd < 4; ++hd) {
        f32x16 S;
#pragma unroll
        for (int i = 0; i < 16; ++i) S[i] = 0.f;
#pragma unroll
        for (int ks = 0; ks < 4; ++ks) S = MFMA32(a[ks], Biq[hd][ks], S);
#pragma unroll
        for (int i = 0; i < 16; ++i) { const float rl = relu_f(S[i]); sc[i] = __builtin_fmaf(w[hd], rl, (hd == 0) ? 0.0f : sc[i]); }
    }
}
DI bf16x8 load_q_frag(const bf16_t* pl, const float* rope, int row, int hd, int ks, int h, float scale) {
    const u32x4 raw = *(const u32x4*)(pl + (size_t)row * 256 + 64 * hd + 16 * ks + 8 * h);
    float x[8];
#pragma unroll
    for (int e = 0; e < 4; ++e) { x[2 * e] = bflo(raw[e]); x[2 * e + 1] = bfhi(raw[e]); }
    if (ks == 0) {
        const u32x4 oth = *(const u32x4*)(pl + (size_t)row * 256 + 64 * hd + 8 * (1 - h));
        const float* rp = rope + (size_t)row * 16;
#pragma unroll
        for (int e = 0; e < 4; ++e) {
            const float o0 = bflo(oth[e]), o1 = bfhi(oth[e]);
            const float c0 = rp[2 * e], s0 = rp[8 + 2 * e], c1 = rp[2 * e + 1], s1 = rp[8 + 2 * e + 1];
            x[2 * e] = h ? (x[2 * e] * c0 + o0 * s0) : (x[2 * e] * c0 - o0 * s0);
            x[2 * e + 1] = h ? (x[2 * e + 1] * c1 + o1 * s1) : (x[2 * e + 1] * c1 - o1 * s1);
        }
    }
    u32x4 w; w.x = pk2(x[0] * scale, x[1] * scale); w.y = pk2(x[2] * scale, x[3] * scale); w.z = pk2(x[4] * scale, x[5] * scale); w.w = pk2(x[6] * scale, x[7] * scale);
    return __builtin_bit_cast(bf16x8, w);
}
DI bf16x8 load_qp_frag(const bf16_t* pl, const float* rope, int row, int hd, int ks, int h, float scale) {
    const u32x2 lo = *(const u32x2*)(pl + (size_t)row * 256 + 64 * hd + 16 * ks + 4 * h), hi = *(const u32x2*)(pl + (size_t)row * 256 + 64 * hd + 16 * ks + 8 + 4 * h);
    float x[8];
    x[0] = bflo(lo.x); x[1] = bfhi(lo.x); x[2] = bflo(lo.y); x[3] = bfhi(lo.y); x[4] = bflo(hi.x); x[5] = bfhi(hi.x); x[6] = bflo(hi.y); x[7] = bfhi(hi.y);
    if (ks == 0) {
        const float* rp = rope + (size_t)row * 16 + 4 * h;
#pragma unroll
        for (int j = 0; j < 4; ++j) { const float cv = rp[j], sv = rp[8 + j], x1 = x[j], x2 = x[j + 4]; x[j] = x1 * cv - x2 * sv; x[j + 4] = x2 * cv + x1 * sv; }
    }
    u32x4 w; w.x = pk2(x[0] * scale, x[1] * scale); w.y = pk2(x[2] * scale, x[3] * scale); w.z = pk2(x[4] * scale, x[5] * scale); w.w = pk2(x[6] * scale, x[7] * scale);
    return __builtin_bit_cast(bf16x8, w);
}
DI void dsa_hist_scan(Frame& F, LAS unsigned* hist, LAS int* need, LAS int* selb, LAS int* ceq, LAS const int* active) {
    const int q = F.tid & 31, sub = F.tid >> 5;
    LAS int* cnts = (LAS int*)(F.lds + DSA_MISC + 3072);
    LAS int* tsub = cnts + 512; LAS int* tabove = tsub + 32;
    {
        int cnt = 0;
#pragma unroll
        for (int b4 = 0; b4 < 4; ++b4) {
            unsigned v[16];
#pragma unroll
            for (int w = 0; w < 16; ++w) v[w] = hist[hidx(q, sub * 64 + b4 * 16 + w)];
            __builtin_amdgcn_sched_barrier(0);
#pragma unroll
            for (int w = 0; w < 16; ++w) cnt += (int)(v[w] & 0xffffu) + (int)(v[w] >> 16);
            __builtin_amdgcn_sched_barrier(0);
        }
        cnts[q * 16 + sub] = cnt;
        __syncthreads();
        int above = 0;
        {
            const LAS u32x4* cp = (const LAS u32x4*)(cnts + q * 16); const u32x4 c0 = cp[0], c1 = cp[1], c2 = cp[2], c3 = cp[3];
            __builtin_amdgcn_sched_barrier(0);
#pragma unroll
            for (int k = 0; k < 16; ++k) { const unsigned c = (k >> 2) == 0 ? c0[k & 3] : (k >> 2) == 1 ? c1[k & 3] : (k >> 2) == 2 ? c2[k & 3] : c3[k & 3]; above += (k > sub) ? (int)c : 0; }
        }
        const int nd = need[q];
        if (above < nd && nd <= above + cnt) { tsub[q] = sub; tabove[q] = above; }
        __syncthreads();
    }
    const int ts = tsub[q], ta = tabove[q], nd = need[q];
    const int w0_ = ts * 64 + sub * 4;
    const unsigned v0 = hist[hidx(q, w0_)], v1 = hist[hidx(q, w0_ + 1)], v2 = hist[hidx(q, w0_ + 2)], v3 = hist[hidx(q, w0_ + 3)];
    __builtin_amdgcn_sched_barrier(0);
    const int c8 = (int)(v0 & 0xffffu) + (int)(v0 >> 16) + (int)(v1 & 0xffffu) + (int)(v1 >> 16) + (int)(v2 & 0xffffu) + (int)(v2 >> 16) + (int)(v3 & 0xffffu) + (int)(v3 >> 16);
    cnts[q * 16 + sub] = c8;
    __syncthreads();
    int above = ta;
    {
        const LAS u32x4* cp = (const LAS u32x4*)(cnts + q * 16); const u32x4 c0 = cp[0], c1 = cp[1], c2 = cp[2], c3 = cp[3];
        __builtin_amdgcn_sched_barrier(0);
#pragma unroll
        for (int k = 0; k < 16; ++k) { const unsigned c = (k >> 2) == 0 ? c0[k & 3] : (k >> 2) == 1 ? c1[k & 3] : (k >> 2) == 2 ? c2[k & 3] : c3[k & 3]; above += (k > sub) ? (int)c : 0; }
    }
    __syncthreads();
    if (active[q] && above < nd && nd <= above + c8) {
        int cum = above; bool done = false;
#pragma unroll
        for (int bk = 7; bk >= 0; --bk) {
            const unsigned v = (bk >> 1) == 3 ? v3 : (bk >> 1) == 2 ? v2 : (bk >> 1) == 1 ? v1 : v0; const int c = (bk & 1) ? (int)(v >> 16) : (int)(v & 0xffffu);
            if (!done && cum + c >= nd) { selb[q] = ts * 128 + sub * 8 + bk; need[q] = nd - cum; ceq[q] = c; done = true; }
            if (!done) cum += c;
        }
    }
    __syncthreads();
}

DI void dsa_item(Frame& Fin, const Params& p, int item) {
    const int b = item & 1, qt = 255 - (item >> 1), q0 = b * SEQ + 32 * qt, nkt = qt + 1;
    int tid = Fin.tid; asm volatile("" : "+v"(tid));
    Frame F = Fin; F.tid = tid; F.lane = tid & 63;
    const int lane = tid & 63, wave = F.wave, r = lane & 31, h = lane >> 5;
    LAS unsigned* hist = (LAS unsigned*)F.lds;
    LAS int* need = (LAS int*)(F.lds + DSA_MISC); LAS int* selb = need + 32; LAS int* ceq = selb + 32; LAS int* active = ceq + 32;
    LAS unsigned* thr = (LAS unsigned*)(active + 32); LAS int* cut = (LAS int*)(thr + 32); LAS int* tief = cut + 32; LAS int* anytie = tief + 32;
    const unsigned char* recs = F.ws + WS_KB + (size_t)b * 256 * TILE_BYTES;
    const float* rope = (const float*)(F.ws + WS_ROPE); const float* Pf = (const float*)(F.ws + WS_PF);
    const bf16_t* Piq = plane(F, PL_IQ); const bf16_t* Pq = plane(F, PL_Q);
    float w[4];
#pragma unroll
    for (int hd = 0; hd < 4; ++hd) w[hd] = Pf[(size_t)(q0 + r) * 256 + PF_IW + hd] * 0.5f;
    bf16x8 Biq[4][4];
#pragma unroll
    for (int hd = 0; hd < 4; ++hd)
#pragma unroll
        for (int ks = 0; ks < 4; ++ks) Biq[hd][ks] = load_q_frag(Piq, rope, q0 + r, hd, ks, h, 0.125f);
    const int qpos = 32 * qt + r;
    if (tid < 32) { const int nv = 32 * qt + tid + 1; need[tid] = nv < 256 ? nv : 256; active[tid] = nv > 256; thr[tid] = 0u; cut[tid] = SEQ; tief[tid] = 0; selb[tid] = 0; ceq[tid] = 0; }
    if (tid == 0) anytie[0] = 0;
    unsigned pre = 0u;
#define DSA_HIST_PASS(PASS) do { \
        for (int i_ = tid; i_ < 32 * 1024 / 4; i_ += 512) *(LAS u32x4*)(hist + 4 * i_) = (u32x4){0u, 0u, 0u, 0u}; \
        __syncthreads(); \
        LAS unsigned* hrow = hist + r; \
        bf16x8 an[4]; \
        if (wave < nkt) dsa_load_ik(recs, wave, lane, an); \
        for (int kt = wave; kt < nkt; kt += 8) { \
            bf16x8 a[4]; \
            _Pragma("unroll") for (int ks = 0; ks < 4; ++ks) a[ks] = an[ks]; \
            if (kt + 8 < nkt) dsa_load_ik(recs, kt + 8, lane, an); \
            f32x16 sc; dsa_tile_scores(a, Biq, w, sc); \
            if (kt < qt) {        \
                _Pragma("unroll") for (int i = 0; i < 16; ++i) { \
                    const unsigned key = f2key(sc[i]); \
                    if (PASS == 0) { __hip_atomic_fetch_add(hrow + ((key >> 22) << 5), 1u + 0xffffu * ((key >> 21) & 1u), __ATOMIC_RELAXED, __HIP_MEMORY_SCOPE_WORKGROUP); } \
                    else if (PASS == 1) { const unsigned val = ((key >> 21) == pre) ? (1u + 0xffffu * ((key >> 10) & 1u)) : 0u; __hip_atomic_fetch_add(hrow + (((key >> 11) & 1023u) << 5), val, __ATOMIC_RELAXED, __HIP_MEMORY_SCOPE_WORKGROUP); } \
                    else { const unsigned val = ((key >> 10) == pre) ? (1u + 0xffffu * (key & 1u)) : 0u; __hip_atomic_fetch_add(hrow + (((key >> 1) & 511u) << 5), val, __ATOMIC_RELAXED, __HIP_MEMORY_SCOPE_WORKGROUP); } \
                } \
            } else {              \
                const int limh = qpos - 32 * kt - 4 * h; \
                _Pragma("unroll") for (int i = 0; i < 16; ++i) { \
                    const unsigned key = f2key(sc[i]); \
                    bool ok = ((i & 3) + 8 * (i >> 2)) <= limh; unsigned bk; \
                    if (PASS == 0) bk = key >> 21; else if (PASS == 1) { ok = ok & ((key >> 21) == pre); bk = (key >> 10) & 2047u; } else { ok = ok & ((key >> 10) == pre); bk = key & 1023u; } \
                    const unsigned val = ok ? (1u + 0xffffu * (bk & 1u)) : 0u; \
                    __hip_atomic_fetch_add(hrow + ((bk >> 1) << 5), val, __ATOMIC_RELAXED, __HIP_MEMORY_SCOPE_WORKGROUP); \
                } \
            } \
        } \
        __syncthreads(); \
        dsa_hist_scan(F, hist, need, selb, ceq, active); \
    } while (0)
    LAS unsigned short* Gm = (LAS unsigned short*)F.lds;
    LAS unsigned short* Em = (LAS unsigned short*)(F.lds + 32768);
    LAS unsigned* tiebm = (LAS unsigned*)(F.lds + 65536);
    LAS unsigned* clist = (LAS unsigned*)(F.lds + 98304);
    LAS int* lcnt = anytie + 32; LAS int* lomin = lcnt + 32; LAS int* himax = lomin + 32; LAS int* fback = himax + 32;
    if (tid < 32) { lcnt[tid] = 0; lomin[tid] = 1024; himax[tid] = -1; } if (tid == 0) fback[0] = 0;
    if (qt >= 8) {
        DSA_HIST_PASS(0); pre = (unsigned)selb[r];
        DSA_HIST_PASS(1); pre = (pre << 11) | (unsigned)selb[r];
    }
    if (tid < 32 && active[tid]) { if (ceq[tid] > need[tid]) { tief[tid] = 1; anytie[0] = 1; } }
    __syncthreads();
    const unsigned P22 = active[r] ? pre : 0u;
    if (anytie[0]) { for (int i = tid; i < 32 * 256; i += 512) tiebm[i] = 0u; }
    __syncthreads();
    {
        const bool tf = tief[r] != 0;
        bf16x8 an[4];
        if (wave < nkt) dsa_load_ik(recs, wave, lane, an);
        for (int kt = wave; kt < nkt; kt += 8) {
            bf16x8 a[4];
#pragma unroll
            for (int ks = 0; ks < 4; ++ks) a[ks] = an[ks];
            if (kt + 8 < nkt) dsa_load_ik(recs, kt + 8, lane, an);
            f32x16 sc; dsa_tile_scores(a, Biq, w, sc);
            const int limh = qpos - 32 * kt - 4 * h;
            unsigned g = 0u, e = 0u;
#pragma unroll
            for (int i = 0; i < 16; ++i) { const int ci = (i & 3) + 8 * (i >> 2); const unsigned k22 = f2key(sc[i]) >> 10; const bool valid = ci <= limh;
                g |= (valid & (k22 > P22)) ? (1u << i) : 0u; e |= (valid & (k22 == P22)) ? (1u << i) : 0u; }
            Gm[kt * 64 + lane] = (unsigned short)g; Em[kt * 64 + lane] = (unsigned short)e;
            if (tf && e) {
#pragma unroll
                for (int i = 0; i < 16; ++i) if ((e >> i) & 1u) { const int kidx = 32 * kt + crow(i, h); const int low = (int)(f2key(sc[i]) & 1023u);
                    __hip_atomic_fetch_or(tiebm + hidx(r, kidx >> 5), 1u << (kidx & 31), __ATOMIC_RELAXED, __HIP_MEMORY_SCOPE_WORKGROUP);
                    __hip_atomic_fetch_min(lomin + r, low, __ATOMIC_RELAXED, __HIP_MEMORY_SCOPE_WORKGROUP); __hip_atomic_fetch_max(himax + r, low, __ATOMIC_RELAXED, __HIP_MEMORY_SCOPE_WORKGROUP);
                    const int pos = __hip_atomic_fetch_add(lcnt + r, 1, __ATOMIC_RELAXED, __HIP_MEMORY_SCOPE_WORKGROUP);
                    if (pos < 64) clist[r * 64 + pos] = ((unsigned)low << 13) | (unsigned)kidx; }
            }
        }
    }
    __syncthreads();
    if (anytie[0]) {
        const int q = tid & 31, sub = tid >> 5; const bool fl = tief[q] != 0, pure = fl && lomin[q] == himax[q];
        LAS int* cnts = (LAS int*)(F.lds + DSA_MISC + 3072);
        unsigned wv[16]; int cnt = 0;
#pragma unroll
        for (int k = 0; k < 16; ++k) { wv[k] = tiebm[hidx(q, sub * 16 + k)]; cnt += __popc(wv[k]); }
        cnts[q * 16 + sub] = cnt;
        __syncthreads();
        int before = 0;
        for (int k = 0; k < sub; ++k) before += cnts[q * 16 + k];
        const int nd = need[q];
        if (pure && before < nd && nd <= before + cnt) {
            int rem = nd - before, pos = SEQ; bool done = false;
#pragma unroll
            for (int k = 0; k < 16; ++k) { const int c = __popc(wv[k]);
                if (!done && rem <= c) { unsigned vv = wv[k]; for (int t = 1; t < rem; ++t) vv &= vv - 1; pos = (sub * 16 + k) * 32 + (__ffs(vv) - 1); done = true; }
                if (!done) rem -= c; }
            cut[q] = pos;
        }
        if (fl && !pure) {
            const int n = lcnt[q];
            if (n > 64) { fback[0] = 1; }
            else {
                for (int e0 = sub; e0 < n; e0 += 16) {
                    const unsigned ce = clist[q * 64 + e0]; const unsigned Ke = ((1023u - (ce >> 13)) << 13) | (ce & 8191u);
                    int rank = 0;
                    for (int f = 0; f < n; ++f) { const unsigned cf = clist[q * 64 + f]; const unsigned Kf = ((1023u - (cf >> 13)) << 13) | (cf & 8191u); rank += (Kf < Ke) ? 1 : 0; }
                    if (rank < nd) { const int kidx = (int)(ce & 8191u), kk = kidx & 31, tl = kidx >> 5, hh = (kk >> 2) & 1, ii = (kk & 3) + 4 * (kk >> 3), slot = tl * 64 + hh * 32 + q;
                        __hip_atomic_fetch_or((LAS unsigned*)F.lds + (slot >> 1), (1u << ii) << (16 * (slot & 1)), __ATOMIC_RELAXED, __HIP_MEMORY_SCOPE_WORKGROUP); }
                }
                if (sub == 0) cut[q] = -1;
            }
        }
        __syncthreads();
    }
#ifndef DSA_CHECK
#define DSA_CHECK 0
#endif
    LAS int* badf = fback + 1;
    unsigned short* chk = (unsigned short*)(F.ws + (size_t)244 * MiB) + (size_t)F.bid * 16384;
    if (DSA_CHECK) {
        if (tid == 0) badf[0] = 0;
        for (int slot = tid; slot < 64 * nkt; slot += 512) { const int rr = slot & 31, hh = (slot >> 5) & 1, kt2 = slot >> 6;
            const int cq = tief[rr] ? cut[rr] : SEQ, cuth = cq - 32 * kt2 - 4 * hh; unsigned le = 0u;
            for (int gq = 0; gq < 4; ++gq) { int c = cuth - 8 * gq + 1; c = c < 0 ? 0 : (c > 4 ? 4 : c); le |= ((1u << c) - 1u) << (4 * gq); }
            chk[slot] = (unsigned short)(Gm[slot] | (Em[slot] & le)); }
        __syncthreads();
        if (tid == 0 && qt >= 8) fback[0] = 1;
        __syncthreads();
    }
    if (fback[0]) {
        DSA_HIST_PASS(2); pre = (pre << 10) | (unsigned)selb[r];
        if (tid < 32) { tief[tid] = (active[tid] && ceq[tid] > need[tid]) ? 1 : 0; cut[tid] = SEQ; }
        __syncthreads();
        const unsigned T = active[r] ? pre : 0u;
        for (int i = tid; i < 32 * 256; i += 512) tiebm[i] = 0u;
        __syncthreads();
        {
            const bool tf = tief[r] != 0;
            for (int kt = wave; kt < nkt; kt += 8) {
                bf16x8 a[4]; dsa_load_ik(recs, kt, lane, a);
                f32x16 sc; dsa_tile_scores(a, Biq, w, sc);
                const int limh = qpos - 32 * kt - 4 * h;
                unsigned g = 0u, e = 0u;
#pragma unroll
                for (int i = 0; i < 16; ++i) { const int ci = (i & 3) + 8 * (i >> 2); const unsigned key = f2key(sc[i]); const bool valid = ci <= limh;
                    g |= (valid & (key > T)) ? (1u << i) : 0u; e |= (valid & (key == T)) ? (1u << i) : 0u; }
                Gm[kt * 64 + lane] = (unsigned short)g; Em[kt * 64 + lane] = (unsigned short)e;
                if (tf && e) {
#pragma unroll
                    for (int i = 0; i < 16; ++i) { const int kidx = 32 * kt + crow(i, h);
                        if ((e >> i) & 1u) __hip_atomic_fetch_or(tiebm + hidx(r, kidx >> 5), 1u << (kidx & 31), __ATOMIC_RELAXED, __HIP_MEMORY_SCOPE_WORKGROUP); }
                }
            }
        }
        __syncthreads();
        {
            const int q = tid & 31, sub = tid >> 5;
            LAS int* cnts = (LAS int*)(F.lds + DSA_MISC + 3072);
            unsigned wv[16]; int cnt = 0;
#pragma unroll
            for (int k = 0; k < 16; ++k) { wv[k] = tiebm[hidx(q, sub * 16 + k)]; cnt += __popc(wv[k]); }
            cnts[q * 16 + sub] = cnt;
            __syncthreads();
            int before = 0;
            for (int k = 0; k < sub; ++k) before += cnts[q * 16 + k];
            const int nd = need[q];
            if (tief[q] && before < nd && nd <= before + cnt) {
                int rem = nd - before, pos = SEQ; bool done = false;
#pragma unroll
                for (int k = 0; k < 16; ++k) { const int c = __popc(wv[k]);
                    if (!done && rem <= c) { unsigned vv = wv[k]; for (int t = 1; t < rem; ++t) vv &= vv - 1; pos = (sub * 16 + k) * 32 + (__ffs(vv) - 1); done = true; }
                    if (!done) rem -= c; }
                cut[q] = pos;
            }
            __syncthreads();
        }
    }
#undef DSA_HIST_PASS
    if (DSA_CHECK && qt >= 8) {
        asm volatile("s_waitcnt vmcnt(0)" ::: "memory"); __syncthreads();
        for (int slot = tid; slot < 64 * nkt; slot += 512) { const int rr = slot & 31, hh = (slot >> 5) & 1, kt2 = slot >> 6;
            const int cq = tief[rr] ? cut[rr] : SEQ, cuth = cq - 32 * kt2 - 4 * hh; unsigned le = 0u;
            for (int gq = 0; gq < 4; ++gq) { int c = cuth - 8 * gq + 1; c = c < 0 ? 0 : (c > 4 ? 4 : c); le |= ((1u << c) - 1u) << (4 * gq); }
            const unsigned short eff = (unsigned short)(Gm[slot] | (Em[slot] & le));
            if (eff != __builtin_nontemporal_load(chk + slot)) badf[0] = 1; }
        __syncthreads();
    }
    const int mycut = tief[r] ? cut[r] : SEQ;
    const int hg = wave >> 2, kw = wave & 3;
    f32x16 O[2][2]; float mrun[2], lrun[2];
#pragma unroll
    for (int j = 0; j < 2; ++j) { mrun[j] = -1e30f; lrun[j] = 0.f;
#pragma unroll
        for (int dt = 0; dt < 2; ++dt)
#pragma unroll
            for (int i = 0; i < 16; ++i) O[j][dt][i] = 0.f; }
    bf16x8 Bq[2][4];
#pragma unroll
    for (int j = 0; j < 2; ++j)
#pragma unroll
        for (int ks = 0; ks < 4; ++ks) Bq[j][ks] = load_qp_frag(Pq, rope, q0 + r, 2 * hg + j, ks, h, 0.125f * 1.4426950408889634f);
    bf16x8 kn[2][4];
    if (kw < nkt) {
#pragma unroll
        for (int j = 0; j < 2; ++j)
#pragma unroll
            for (int ks = 0; ks < 4; ++ks) kn[j][ks] = ld16(recs, (unsigned)kw * (unsigned)TILE_BYTES + TR_K + (unsigned)(((2 * hg + j) * 4 + ks) * 64 + lane) * 16u);
    }
    for (int kt = kw; kt < nkt; kt += 4) {
        bf16x8 vf[2][2][2];
#pragma unroll
        for (int j = 0; j < 2; ++j)
#pragma unroll
            for (int dt = 0; dt < 2; ++dt) { const unsigned voff = (unsigned)kt * (unsigned)TILE_BYTES + TR_V + (unsigned)((((2 * hg + j) * 2 + dt) * 2) * 64 + lane) * 16u;
                vf[j][dt][0] = ld16(recs, voff); vf[j][dt][1] = ld16(recs, voff + 1024u); }
        unsigned msk;
        {
            const unsigned g = Gm[kt * 64 + lane], e = Em[kt * 64 + lane];
            const int cuth = mycut - 32 * kt - 4 * h;
            unsigned le = 0u;
#pragma unroll
            for (int gq = 0; gq < 4; ++gq) { int c = cuth - 8 * gq + 1; c = c < 0 ? 0 : (c > 4 ? 4 : c); le |= ((1u << c) - 1u) << (4 * gq); }
            msk = g | (e & le);
        }
        f32x16 S0, S1;
#pragma unroll
        for (int i = 0; i < 16; ++i) { S0[i] = 0.f; S1[i] = 0.f; }
#pragma unroll
        for (int ks = 0; ks < 4; ++ks) { S0 = MFMA32(kn[0][ks], Bq[0][ks], S0); S1 = MFMA32(kn[1][ks], Bq[1][ks], S1); }
        __builtin_amdgcn_sched_barrier(0);
        if (kt + 4 < nkt) {
#pragma unroll
            for (int j = 0; j < 2; ++j)
#pragma unroll
                for (int ks = 0; ks < 4; ++ks) kn[j][ks] = ld16(recs, (unsigned)(kt + 4) * (unsigned)TILE_BYTES + TR_K + (unsigned)(((2 * hg + j) * 4 + ks) * 64 + lane) * 16u);
        }
        __builtin_amdgcn_sched_barrier(0);
#pragma unroll
        for (int j = 0; j < 2; ++j) {
            f32x16& S = j ? S1 : S0;
            float mx = -1e30f;
#pragma unroll
            for (int i = 0; i < 16; ++i) mx = ((msk >> i) & 1u) ? max_f(mx, S[i]) : mx;
            mx = xmax32(mx);
            const float mnew = fmaxf(mrun[j], mx), alpha = __builtin_amdgcn_exp2f(mrun[j] - mnew);
            float rs = 0.f;
#pragma unroll
            for (int i = 0; i < 16; ++i) { const float pv = ((msk >> i) & 1u) ? __builtin_amdgcn_exp2f(S[i] - mnew) : 0.f; S[i] = pv; rs += pv; }
            rs = xsum32(rs);
            lrun[j] = lrun[j] * alpha + rs; mrun[j] = mnew;
            const bf16x8 pb0 = pack8(S, 0), pb1 = pack8(S, 1);
            if (__builtin_amdgcn_ballot_w64(alpha != 1.0f) != 0ull) {
#pragma unroll
                for (int dt = 0; dt < 2; ++dt) O[j][dt] = O[j][dt] * alpha;
            }
#pragma unroll
            for (int dt = 0; dt < 2; ++dt) {
                O[j][dt] = MFMA32(vf[j][dt][0], pb0, O[j][dt]);
                O[j][dt] = MFMA32(vf[j][dt][1], pb1, O[j][dt]);
            }
        }
        __builtin_amdgcn_sched_barrier(0);
    }
    __syncthreads();
    LAS float* slots = (LAS float*)F.lds; constexpr int SLOT_F = (64 + 4) * 64;
#pragma unroll
    for (int round = 0; round < 2; ++round) {
        const int half = 2 >> round;
        if (kw >= half && kw < 2 * half) {
            LAS float* s = slots + (hg * 2 + (kw - half)) * SLOT_F + lane;
#pragma unroll
            for (int j = 0; j < 2; ++j) {
#pragma unroll
                for (int dt = 0; dt < 2; ++dt)
#pragma unroll
                    for (int i = 0; i < 16; ++i) s[((j * 2 + dt) * 16 + i) * 64] = O[j][dt][i];
                s[(64 + j) * 64] = mrun[j]; s[(66 + j) * 64] = lrun[j];
            }
        }
        __syncthreads();
        if (kw < half) {
            const LAS float* s = slots + (hg * 2 + kw) * SLOT_F + lane;
#pragma unroll
            for (int j = 0; j < 2; ++j) {
                const float m2 = s[(64 + j) * 64], l2 = s[(66 + j) * 64];
                const float mn = fmaxf(mrun[j], m2), a1 = __builtin_amdgcn_exp2f(mrun[j] - mn), a2 = __builtin_amdgcn_exp2f(m2 - mn);
                lrun[j] = lrun[j] * a1 + l2 * a2; mrun[j] = mn;
#pragma unroll
                for (int dt = 0; dt < 2; ++dt)
#pragma unroll
                    for (int i = 0; i < 16; ++i) O[j][dt][i] = O[j][dt][i] * a1 + s[((j * 2 + dt) * 16 + i) * 64] * a2;
            }
        }
        __syncthreads();
    }
    LAS bf16_t* tile = (LAS bf16_t*)F.lds;
    if (kw == 0) {
#pragma unroll
        for (int j = 0; j < 2; ++j) {
            const int hd = 2 * hg + j; const float inv = 1.f / lrun[j];
#pragma unroll
            for (int dt = 0; dt < 2; ++dt)
#pragma unroll
                for (int g = 0; g < 4; ++g) { u32x2 v; v.x = pk2(O[j][dt][4 * g] * inv, O[j][dt][4 * g + 1] * inv); v.y = pk2(O[j][dt][4 * g + 2] * inv, O[j][dt][4 * g + 3] * inv);
                    *(LAS u32x2*)(tile + r * 264 + 64 * hd + 32 * dt + 8 * g + 4 * h) = v; }
        }
    }
    __syncthreads();
    {
        bf16_t* Y = (bf16_t*)(F.ws + WS_Y);
#pragma unroll
        for (int it = 0; it < 2; ++it) { const int c = it * 512 + tid, row = c >> 5, c16 = c & 31;
            const u32x4 v = *(const LAS u32x4*)(tile + row * 264 + c16 * 8);
            *(u32x4*)(Y + (size_t)(q0 + row) * 1024 + 512 + c16 * 8) = (DSA_CHECK && badf[0]) ? (u32x4){0x7fc07fc0u, 0x7fc07fc0u, 0x7fc07fc0u, 0x7fc07fc0u} : v; }
    }
    __syncthreads();
}
DI void phase_mix(Frame& F, const Params& p, int layer, int qidx) {
#ifndef PROBE_MIX
#define PROBE_MIX 0
#endif
    if (F.bid < 8) { gdn_scan(F, p, layer, F.bid); if (PROBE_MIX == 1 && layer == 0) gdn_scan(F, p, layer, F.bid);
        asm volatile("s_waitcnt vmcnt(0)" ::: "memory"); __syncthreads(); __builtin_amdgcn_fence(__ATOMIC_ACQUIRE, "agent"); asm volatile("s_waitcnt vmcnt(0)" ::: "memory"); __syncthreads();
        gdn_finalize_bh(F, p, layer, F.bid); __syncthreads(); }
    LAS int* itemw = (LAS int*)(F.lds + DSA_MISC + 2048);
    for (int rr = 0; rr < ((PROBE_MIX == 2 && layer == 0) ? 2 : 1); ++rr) {
        unsigned* qctr = (unsigned*)(F.ws + WS_CTL) + CW_QCTR + 64 * (qidx + 4 * rr);
        for (;;) {
            if (F.tid == 0) itemw[0] = (int)atomicAdd(qctr, 1u);
            __syncthreads();
            const int item = itemw[0];
            __syncthreads();
            if (item >= 512) break;
            dsa_item(F, p, item);
        }
    }
}

constexpr size_t WS_KF = 35 * MiB, WS_VF = 23 * MiB;
DI void xa_relayout(Frame& F) {
    for (int i = F.bid * 512 + F.tid; i < 2 * 2 * 65536; i += F.G * 512) {
        const int isv = i >> 17, l = (i >> 16) & 1, c = i & 65535, lane = c & 63, r = lane & 31, h = lane >> 5, f = (c >> 6) & 127, bh = c >> 13, b = bh >> 2, hd = bh & 3;
        if (!isv) { const int kt = f >> 4, ks = f & 15;
            const bf16_t* Km = (const bf16_t*)(F.ws + WS_KMEM) + (size_t)l * MEMROWS * DM;
            const u32x4 v = *(const u32x4*)(Km + (size_t)(b * MEMLEN + 32 * kt + r) * DM + 256 * hd + 16 * ks + 8 * h);
            *(u32x4*)(F.ws + WS_KF + (size_t)l * MiB + (size_t)c * 16) = v; }
        else { const int dt = f >> 4, kt = (f >> 1) & 7, s = f & 1;
            const bf16_t* Vt = (const bf16_t*)(F.ws + WS_VMEMT) + (size_t)l * DM * MEMROWS;
            const bf16_t* vrow = Vt + (size_t)(256 * hd + 32 * dt + r) * MEMROWS + b * MEMLEN + 32 * kt + 16 * s + 4 * h;
            const u32x2 lo = *(const u32x2*)(vrow), hi = *(const u32x2*)(vrow + 8);
            u32x4 v; v.x = lo.x; v.y = lo.y; v.z = hi.x; v.w = hi.y;
            *(u32x4*)(F.ws + WS_VF + (size_t)l * MiB + (size_t)c * 16) = v; }
    }
}

DI void xa_unit(Frame& F, int layer, int pm, int hd) {
    const int tid = F.tid, lane = F.lane, wave = F.wave, r = lane & 31, h = lane >> 5, b = pm >> 5;
    const bf16_t* Q = (const bf16_t*)(F.ws + WS_Q); bf16_t* Oo = (bf16_t*)(F.ws + WS_O);
    const unsigned char* KF = F.ws + WS_KF + (size_t)layer * MiB + (size_t)(b * 4 + hd) * 131072;
    const unsigned char* VF = F.ws + WS_VF + (size_t)layer * MiB + (size_t)(b * 4 + hd) * 131072;
    const int q0 = pm * 256 + wave * 32; const unsigned t16 = 16u * tid;
    LAS unsigned char* lds = F.lds;
    {
        u32x4 v[16];
#pragma unroll
        for (int i = 0; i < 16; ++i) v[i] = *(const u32x4*)(KF + (unsigned)i * 8192u + t16);
#pragma unroll
        for (int i = 0; i < 16; ++i) *(LAS u32x4*)(lds + i * 8192 + t16) = v[i];
    }
    bf16x8 Qf[16];
#pragma unroll
    for (int ks = 0; ks < 16; ++ks) Qf[ks] = *(const bf16x8*)(Q + (size_t)(q0 + r) * DM + 256 * hd + 16 * ks + 8 * h);
    __syncthreads();
    f32x16 S[8];
#pragma unroll
    for (int kt = 0; kt < 8; ++kt) {
#pragma unroll
        for (int i = 0; i < 16; ++i) S[kt][i] = 0.f;
#pragma unroll
        for (int ks = 0; ks < 16; ++ks) S[kt] = MFMA32(*(const LAS bf16x8*)(lds + ((kt * 16 + ks) * 64 + lane) * 16), Qf[ks], S[kt]);
    }
    float mx = -1e30f;
#pragma unroll
    for (int kt = 0; kt < 8; ++kt)
#pragma unroll
        for (int i = 0; i < 16; ++i) mx = max_f(mx, S[kt][i]);
    mx = xmax32(mx);
    float sum = 0.f;
    bf16x8 pb[8][2];
#pragma unroll
    for (int kt = 0; kt < 8; ++kt) {
#pragma unroll
        for (int i = 0; i < 16; ++i) { const float e = __expf(S[kt][i] - mx); S[kt][i] = e; sum += e; }
        pb[kt][0] = pack8(S[kt], 0); pb[kt][1] = pack8(S[kt], 1);
    }
    sum = xsum32(sum);
    const float inv = 1.f / sum;
    __syncthreads();
    {
        u32x4 v[16];
#pragma unroll
        for (int i = 0; i < 16; ++i) v[i] = *(const u32x4*)(VF + (unsigned)i * 8192u + t16);
#pragma unroll
        for (int i = 0; i < 16; ++i) *(LAS u32x4*)(lds + i * 8192 + t16) = v[i];
    }
    __syncthreads();
    f32x16 O[8];
#pragma unroll
    for (int dt = 0; dt < 8; ++dt) {
#pragma unroll
        for (int i = 0; i < 16; ++i) O[dt][i] = 0.f;
#pragma unroll
        for (int kt = 0; kt < 8; ++kt)
#pragma unroll
            for (int s2 = 0; s2 < 2; ++s2) O[dt] = MFMA32(*(const LAS bf16x8*)(lds + (((dt * 8 + kt) * 2 + s2) * 64 + lane) * 16), pb[kt][s2], O[dt]);
    }
    __syncthreads();
    LAS bf16_t* tile = (LAS bf16_t*)(lds + wave * 16896);
#pragma unroll
    for (int dt = 0; dt < 8; ++dt)
#pragma unroll
        for (int g = 0; g < 4; ++g) { u32x2 v; v.x = pk2(O[dt][4 * g] * inv, O[dt][4 * g + 1] * inv); v.y = pk2(O[dt][4 * g + 2] * inv, O[dt][4 * g + 3] * inv);
            *(LAS u32x2*)(tile + r * 264 + 32 * dt + 8 * g + 4 * h) = v; }
    asm volatile("s_waitcnt lgkmcnt(0)" ::: "memory");
#pragma unroll
    for (int hb = 0; hb < 2; ++hb) {
        u32x4 v[8];
#pragma unroll
        for (int k = 0; k < 8; ++k) { const int c = (hb * 8 + k) * 64 + lane, row = c >> 5, c16 = c & 31; v[k] = *(const LAS u32x4*)(tile + row * 264 + c16 * 8); }
        __builtin_amdgcn_sched_barrier(0);
#pragma unroll
        for (int k = 0; k < 8; ++k) { const int c = (hb * 8 + k) * 64 + lane, row = c >> 5, c16 = c & 31; *(u32x4*)(Oo + (size_t)(q0 + row) * DM + 256 * hd + c16 * 8) = v[k]; }
    }
    asm volatile("s_waitcnt lgkmcnt(0)" ::: "memory");
}

#ifndef PROBE_PHASE
#define PROBE_PHASE (-1)
#endif
#ifndef PROBE_N
#define PROBE_N 2
#endif
constexpr int CW_BAR = 4096;
constexpr size_t WS_DUMMY = 244 * MiB;
__global__ void __launch_bounds__(512, 2) fwd_kernel(Params p) {
    extern __shared__ __attribute__((aligned(16))) unsigned char lds_raw[];
    cg::grid_group grid = cg::this_grid();
    Frame F;
    const int s_wave = __builtin_amdgcn_readfirstlane((int)threadIdx.x >> 6);
#define FRESH() do { unsigned z_ = 0u; asm volatile("" : "+v"(z_)); int sw_ = s_wave; asm volatile("" : "+s"(sw_)); \
        const int t_ = sw_ * 64 + (int)__builtin_amdgcn_mbcnt_hi(~0u, __builtin_amdgcn_mbcnt_lo(~0u, z_)); __attribute__((address_space(1))) unsigned char* w_ = (__attribute__((address_space(1))) unsigned char*)p.ws; asm volatile("" : "+s"(w_));   \
        LAS unsigned char* l_ = (LAS unsigned char*)lds_raw; asm volatile("" : "+s"(l_)); F.lds = l_; F.ws = (unsigned char*)w_; F.tid = t_; F.lane = t_ & 63; F.wave = __builtin_amdgcn_readfirstlane(t_ >> 6); F.G = gridDim.x; F.bid = blockIdx.x; } while (0)
#define XB ((bf16_t*)(F.ws + WS_XB))
#define H ((bf16_t*)(F.ws + WS_H))
#define PART ((float*)(F.ws + WS_PART))
#define SA ((bf16_t*)(F.ws + WS_SLOTA))
#define SB ((bf16_t*)(F.ws + WS_SLOTB))
#define XM (p.out)
#define ring (F.lds)
    volatile LAS unsigned* barst = (volatile LAS unsigned*)((LAS unsigned char*)lds_raw + LDS_BYTES - 64);
    if (threadIdx.x < 2) barst[threadIdx.x] = 0u;
    __syncthreads();
    XcdBarrier bar = xcd_barrier_post((unsigned*)(p.ws + WS_CTL) + CW_BAR, barst);
#define SYNC() do { FRESH(); xcd_barrier(bar, F.tid); FRESH(); } while (0)
#define REP(id) for (int rep_ = 0; rep_ < ((PROBE_PHASE == (id) && l == 0) ? PROBE_N : 1); ++rep_)
    FRESH();
    { const int l = 0; REP(0) {
    prologue(F, p);
    grid.sync(); FRESH(); } }
#pragma unroll 1
    for (int l = 0; l < DEPTH; ++l) {
        REP(2) {
        conv_for(F, p, l, 1); __syncthreads();
        { pg8::Gemm g{XB, SA, MTOK, 2 * FF, DM}; pg8::StaticOrder S; S.init(MTOK, 2 * FF, F.G, F.bid); pg8::EpiSwiglu E{H, PART, FF};
          pg8::gemm_phase<pg8::EpiSwiglu, pg8::StaticOrder, true, true>(ring, g, S, E, F.tid); }
        FRESH();
        if (l == 0 && F.G == 256 && F.bid >= 128 && F.bid < 160) {
            const int j = (F.bid - 128) >> 3, c8 = (F.bid - 128) & 7, ll = j >> 1, isv = j & 1;
            const bf16_t* memn = (const bf16_t*)(F.ws + WS_MEMN) + (size_t)ll * MEMROWS * DM;
            const bf16_t* Wt = (const bf16_t*)(F.ws + WS_WKV) + (size_t)(2 * ll + isv) * DM * DM;
            pg8::StaticOrder S2;
            if (!isv) { pg8::Gemm g2{memn, Wt, MEMROWS, DM, DM}; S2.init(MEMROWS, DM, 8, c8);
                pg8::EpiScale E2{(bf16_t*)(F.ws + WS_KMEM) + (size_t)ll * MEMROWS * DM, DM, 0, nullptr, 1.f, nullptr, 1 << 30};
                pg8::gemm_phase<pg8::EpiScale, pg8::StaticOrder, true, true>(ring, g2, S2, E2, F.tid); }
            else { pg8::Gemm g2{Wt, memn, DM, MEMROWS, DM}; S2.init(DM, MEMROWS, 8, c8);
                pg8::EpiScale E2{(bf16_t*)(F.ws + WS_VMEMT) + (size_t)ll * DM * MEMROWS, MEMROWS, 0, nullptr, 1.f, nullptr, 1 << 30};
                pg8::gemm_phase<pg8::EpiScale, pg8::StaticOrder, true, true>(ring, g2, S2, E2, F.tid); }
        }
        SYNC(); }
        REP(3) {
        conv_for(F, p, l, 2); __syncthreads();
        { pg8::Gemm g{H, SB, MTOK, DM, FF}; pg8::StaticOrder S; S.init(MTOK, DM, F.G, F.bid); pg8::EpiResid E{(l == 0 && rep_ == 0) ? p.in[0] : nullptr, XB, PART, 0.5f, rep_ > 0};
          pg8::gemm_phase<pg8::EpiResid, pg8::StaticOrder, true, true>(ring, g, S, E, F.tid); }
        SYNC(); }
        REP(4) {
        if (l == 0) xa_relayout(F);
        conv_for(F, p, l, 3); __syncthreads();
        { pg8::Gemm g{XB, SA, MTOK, NMIXP, DM}; pg8::StaticOrder S; S.init(MTOK, NMIXP, F.G, F.bid);
          pg8::EpiScale E{(bf16_t*)(F.ws + WS_P), 256, (size_t)MTOK * 256, PART, 1.f, (float*)(F.ws + WS_PF), 11};
          pg8::gemm_phase<pg8::EpiScale, pg8::StaticOrder, true, true>(ring, g, S, E, F.tid); }
        SYNC(); }
        REP(5) {
        phase_prep(F, p, l);
        SYNC(); }
        REP(6) {
        phase_mix(F, p, l, 2 * l + rep_);
        SYNC(); }
        REP(7) {
        conv_for(F, p, l, 4); __syncthreads();
        { pg8::Gemm g{(const bf16_t*)(F.ws + WS_Y), SB, MTOK, DM, DM}; pg8::StaticOrder S; S.init(MTOK, DM, F.G, F.bid); pg8::EpiResid E{nullptr, XB, PART, 1.f, rep_ > 0};
          pg8::gemm_phase<pg8::EpiResid, pg8::StaticOrder, true, true>(ring, g, S, E, F.tid); }
        SYNC(); }
        REP(8) {
        conv_for(F, p, l, 5); __syncthreads();
        { pg8::Gemm g{XB, SA, MTOK, DM, DM}; pg8::StaticOrder S; S.init(MTOK, DM, F.G, F.bid);
          pg8::EpiScale E{(bf16_t*)(F.ws + WS_Q), DM, 0, PART, 0.0625f, nullptr, 1 << 30};
          pg8::gemm_phase<pg8::EpiScale, pg8::StaticOrder, true, true>(ring, g, S, E, F.tid); }
        SYNC(); }
        REP(9) {
        for (int u = F.bid; u < 256; u += F.G) { xa_unit(F, l, u >> 2, u & 3); __syncthreads(); }
        SYNC(); }
        REP(10) {
        conv_for(F, p, l, 6); __syncthreads();
        { pg8::Gemm g{(const bf16_t*)(F.ws + WS_O), SB, MTOK, DM, DM}; pg8::StaticOrder S; S.init(MTOK, DM, F.G, F.bid); pg8::EpiResid E{nullptr, XB, PART, 1.f, rep_ > 0};
          pg8::gemm_phase<pg8::EpiResid, pg8::StaticOrder, true, true>(ring, g, S, E, F.tid); }
        SYNC(); }
        REP(11) {
        conv_for(F, p, l, 7); __syncthreads();
        { pg8::Gemm g{XB, SA, MTOK, 2 * FF, DM}; pg8::StaticOrder S; S.init(MTOK, 2 * FF, F.G, F.bid); pg8::EpiSwiglu E{H, PART, FF};
          pg8::gemm_phase<pg8::EpiSwiglu, pg8::StaticOrder, true, true>(ring, g, S, E, F.tid); }
        SYNC(); }
        REP(12) {
        if (l + 1 < DEPTH) { conv_for(F, p, l + 1, 0); __syncthreads(); }
        { pg8::Gemm g{H, SB, MTOK, DM, FF}; pg8::StaticOrder S; S.init(MTOK, DM, F.G, F.bid); pg8::EpiResid E{nullptr, XB, PART, 0.5f, rep_ > 0};
          pg8::gemm_phase<pg8::EpiResid, pg8::StaticOrder, true, true>(ring, g, S, E, F.tid); }
        SYNC(); }
    }
    {
        const int gw = F.bid * 8 + F.wave, NGW = F.G * 8, lane = F.lane;
        for (int m0 = gw; m0 < MTOK; m0 += 2 * NGW) {
            u32x2 v[2][4]; float rstd[2];
#pragma unroll
            for (int k = 0; k < 2; ++k) { const int mrow = m0 + k * NGW;
                const f32x4* pp = (const f32x4*)(PART + (size_t)mrow * 16);
                const f32x4 a = pp[0], b = pp[1], c = pp[2], d = pp[3];
                const float s = (((a[0] + a[1]) + (a[2] + a[3])) + ((b[0] + b[1]) + (b[2] + b[3]))) + (((c[0] + c[1]) + (c[2] + c[3])) + ((d[0] + d[1]) + (d[2] + d[3])));
                rstd[k] = rsqrtf(s * (1.f / DM) + EPS);
                const u32x2* xr = (const u32x2*)(XB + (size_t)mrow * DM) + lane;
#pragma unroll
                for (int j = 0; j < 4; ++j) v[k][j] = xr[64 * j]; }
            const f32x4* gr = (const f32x4*)p.in[32] + lane;
#pragma unroll
            for (int k = 0; k < 2; ++k) { f32x4* orow = (f32x4*)(XM + (size_t)(m0 + k * NGW) * DM) + lane;
#pragma unroll
                for (int j = 0; j < 4; ++j) { const f32x4 xv = {bflo(v[k][j].x), bfhi(v[k][j].x), bflo(v[k][j].y), bfhi(v[k][j].y)}; orow[64 * j] = xv * rstd[k] * gr[64 * j]; } }
        }
    }
}

extern "C" void kernel_launch(void* const* d_in, const int* in_sizes, int n_in, void* d_out, int out_size, void* d_ws, size_t ws_size, hipStream_t stream) {
    static int grid_blocks = 0;
    if (!grid_blocks) {
        int dev = 0, cus = 0, per_cu = 0;
        if (n_in != 33 || out_size != MTOK * DM || ws_size < WS_END) { fprintf(stderr, "kernel_launch: unexpected sizes n_in %d out %d ws %zu (need %zu)\n", n_in, out_size, ws_size, (size_t)WS_END); grid_blocks = -1; return; }
        (void)hipGetDevice(&dev);
        (void)hipDeviceGetAttribute(&cus, hipDeviceAttributeMultiprocessorCount, dev);
        (void)hipFuncSetAttribute((const void*)fwd_kernel, hipFuncAttributeMaxDynamicSharedMemorySize, LDS_BYTES);
        (void)hipOccupancyMaxActiveBlocksPerMultiprocessor(&per_cu, fwd_kernel, 512, LDS_BYTES);
        fprintf(stderr, "kernel_launch: cus %d per_cu %d ws %zu\n", cus, per_cu, ws_size);
        grid_blocks = (per_cu >= 1) ? cus : -1;
    }
    if (grid_blocks < 0) return;
    (void)hipMemsetAsync((char*)d_ws + WS_CTL, 0, 65536, stream);
    Params p{};
    for (int i = 0; i < 33; ++i) p.in[i] = (const float*)d_in[i];
    p.out = (float*)d_out; p.ws = (unsigned char*)d_ws;
    void* args[] = {&p};
    hipError_t e = hipLaunchCooperativeKernel((void*)fwd_kernel, dim3(grid_blocks), dim3(512), args, LDS_BYTES, stream);
    if (e != hipSuccess) fprintf(stderr, "cooperative launch failed: %s (grid %d)\n", hipGetErrorString(e), grid_blocks);
}
```

```cpp
#include <hip/hip_runtime.h>
#include <hip/hip_cooperative_groups.h>
#include <cstdio>
#include <cstdint>
namespace cg = cooperative_groups;

#define LAS __attribute__((address_space(3)))
#define DI __device__ __forceinline__
typedef unsigned short bf16_t;
typedef short bf16x8 __attribute__((ext_vector_type(8)));
typedef float f32x4 __attribute__((ext_vector_type(4)));
typedef float f32x2 __attribute__((ext_vector_type(2)));
typedef float f32x16 __attribute__((ext_vector_type(16)));
typedef unsigned u32x4 __attribute__((ext_vector_type(4)));
typedef unsigned u32x2 __attribute__((ext_vector_type(2)));
typedef __bf16 bf2_t __attribute__((ext_vector_type(2)));

constexpr int BATCH = 2, SEQ = 8192, DM = 1024, MTOK = BATCH * SEQ, FF = 2816, DEPTH = 2;
constexpr int NMIX = 3020, NMIXP = 3072, MEMLEN = 256, MEMROWS = BATCH * MEMLEN;
constexpr float EPS = 1e-6f;

DI unsigned pk2(float lo, float hi) { f32x2 v = {lo, hi}; bf2_t b = __builtin_convertvector(v, bf2_t); return __builtin_bit_cast(unsigned, b); }
DI float bf2f(unsigned short u) { return __uint_as_float(((unsigned)u) << 16); }
DI float bflo(unsigned u) { return __uint_as_float(u << 16); }
DI float bfhi(unsigned u) { return __uint_as_float(u & 0xffff0000u); }
DI float silu_f(float x) { return x * __builtin_amdgcn_rcpf(1.f + __expf(-x)); }
DI float gelu_tanh(float x) { const float u = 0.7978845608028654f * (x + 0.044715f * x * x * x); const float t = 1.f - 2.f * __builtin_amdgcn_rcpf(1.f + __expf(2.f * u)); return 0.5f * x * (1.f + t); }
template <int X> DI float shx(float v) { static_assert(X == 1 || X == 2 || X == 4 || X == 8 || X == 16, "xor within 32 lanes"); return __int_as_float(__builtin_amdgcn_ds_swizzle(__float_as_int(v), (X << 10) | 0x1f)); }
DI float xsum32(float v) { auto r = __builtin_amdgcn_permlane32_swap(__float_as_uint(v), __float_as_uint(v), false, false); return __uint_as_float(r[0]) + __uint_as_float(r[1]); }
DI float xmax32(float v) { auto r = __builtin_amdgcn_permlane32_swap(__float_as_uint(v), __float_as_uint(v), false, false); return fmaxf(__uint_as_float(r[0]), __uint_as_float(r[1])); }
DI float wave_sum(float v) { v += shx<1>(v); v += shx<2>(v); v += shx<4>(v); v += shx<8>(v); v += shx<16>(v); return xsum32(v); }
namespace pg8 {
#define PG8_LAS __attribute__((address_space(3)))
typedef unsigned short bf16_t;
typedef short bf16x8 __attribute__((ext_vector_type(8)));
typedef float f32x4 __attribute__((ext_vector_type(4)));
typedef unsigned u32x4 __attribute__((ext_vector_type(4)));
constexpr int BM = 256, BK = 64, HALF = 128, HTB = HALF * BK * 2  , STAGE_BYTES = 8 * HTB, NXCD = 8, WGM = 8;

__host__ __device__ __forceinline__ int lds_byte(int r, int c) { const int st = (r >> 4) * 2 + (c >> 5), rr = r & 15, cc = c & 31, ob = rr * 64 + cc * 2; return st * 1024 + (ob ^ (((ob >> 9) & 1) << 5)); }
__host__ __device__ __forceinline__ void stage_rc(int b, int& R, int& C) { const int st = b / 1024, sb = b % 1024, swz = sb ^ (((sb >> 9) & 1) << 5); R = (st >> 1) * 16 + swz / 64; C = (st & 1) * 32 + (swz % 64) / 2; }
__host__ __device__ __forceinline__ int perm32(int rho) { const int n = rho >> 4, i = rho & 15; return 8 * (i >> 2) + 4 * n + (i & 3); }

struct Unit { int pm, pn; };
struct Gemm { const bf16_t* A; const bf16_t* Bt; int M, N, K; };

struct StaticOrder {
    int nM, nN, nwg, G, c;
    __host__ __device__ void init(int M, int N, int G_, int c_) { nM = M / BM; nN = N / BM; nwg = nM * nN; G = G_; c = c_; }
    __host__ __device__ bool next(int i, Unit& u) const {
        const long L = (long)i * G + c; if (L >= nwg) return false;
        int wgid = (int)L; { const int q = nwg / NXCD, r = nwg % NXCD, xcd = wgid % NXCD, off = wgid / NXCD; wgid = (xcd < r ? xcd * (q + 1) : r * (q + 1) + (xcd - r) * q) + off; }
        const int nig = WGM * nN, gid = wgid / nig, fm = gid * WGM, gsz = (nM - fm) < WGM ? (nM - fm) : WGM;
        u.pm = fm + ((wgid % nig) % gsz); u.pn = (wgid % nig) / gsz; return true;
    }
    __device__ __forceinline__ void a_ready(const Unit&) const {}
    __device__ __forceinline__ void done(const Unit&) const {}
};


__device__ __forceinline__ void load_rstd(const float* part, int row0, int fq, float (&rs)[2][4]) {
#pragma unroll
    for (int ai = 0; ai < 2; ++ai)
#pragma unroll
        for (int m = 0; m < 4; ++m) {
            const f32x4 p = *(const f32x4*)(part + (size_t)(row0 + ai * HALF + m * 16) * 16 + 4 * fq);
            float s = (p[0] + p[1]) + (p[2] + p[3]);
            s += shx<16>(s); s = xsum32(s);
            rs[ai][m] = rsqrtf(s * (1.0f / 1024.0f) + 1e-6f);
        }
}
__device__ __forceinline__ void rstd_issue_(const float* part, int row0, int tid, f32x4& r0, f32x4& r1) {
    asm volatile("" : "+v"(tid));
    const float* p = part + (size_t)(row0 + (tid >> 1)) * 16 + 8 * (tid & 1); r0 = *(const f32x4*)p; r1 = *(const f32x4*)(p + 4);
}
__device__ __forceinline__ void rstd_finish_(LAS float* dst, int tid, const f32x4& r0, const f32x4& r1) {
    asm volatile("" : "+v"(tid));
    float s = ((r0[0] + r0[1]) + (r0[2] + r0[3])) + ((r1[0] + r1[1]) + (r1[2] + r1[3]));
    s += shx<1>(s);
    if (!(tid & 1)) dst[tid >> 1] = rsqrtf(s * (1.0f / 1024.0f) + 1e-6f);
}
__device__ __forceinline__ void read_rstd(const LAS float* rsl, int wr, int fr, float (&rs)[2][4]) {
#pragma unroll
    for (int ai = 0; ai < 2; ++ai)
#pragma unroll
        for (int m = 0; m < 4; ++m) rs[ai][m] = rsl[ai * HALF + wr * 64 + m * 16 + fr];
}
struct EpiSwiglu {
    static constexpr bool PERM = true, AFTER_DRAIN = false, RSTD = true;
    bf16_t* H; const float* part; int ldh;
    __device__ __forceinline__ void rstd_issue(const Unit& u, int tid, f32x4& r0, f32x4& r1) const { rstd_issue_(part, u.pm * BM, tid, r0, r1); }
    __device__ __forceinline__ void rstd_finish(LAS float* dst, int tid, const f32x4& r0, const f32x4& r1) const { rstd_finish_(dst, tid, r0, r1); }
    __device__ __forceinline__ void operator()(const f32x4 (&acc)[2][2][4][2], const Unit& u, int wr, int wc, int fr, int fq, const LAS float* rsl) const {
        float rs[2][4]; read_rstd(rsl, wr, fr, rs);
        const int col0 = u.pn * HALF + wc * 32 + 8 * fq;
#pragma unroll
        for (int ai = 0; ai < 2; ++ai)
#pragma unroll
            for (int m = 0; m < 4; ++m) {
                const float r = rs[ai][m];
                float hv[8];
#pragma unroll
                for (int n = 0; n < 2; ++n)
#pragma unroll
                    for (int e = 0; e < 4; ++e) { const float g = acc[ai][0][m][n][e] * r, up = acc[ai][1][m][n][e] * r; hv[4 * n + e] = silu_f(g) * up; }
                u32x4 w; w.x = pk2(hv[0], hv[1]); w.y = pk2(hv[2], hv[3]); w.z = pk2(hv[4], hv[5]); w.w = pk2(hv[6], hv[7]);
                *(u32x4*)(H + (size_t)(u.pm * BM + ai * HALF + wr * 64 + m * 16 + fr) * ldh + col0) = w;
            }
    }
};
struct EpiResid {
    static constexpr bool PERM = true, AFTER_DRAIN = false, RSTD = false;
    const float* base32; bf16_t* xb; float* part; float scale; bool dry;
    __device__ __forceinline__ void finish(const f32x4 (&acc)[2][2][4][2], const f32x4 (&bv)[4][2][2], const Unit& u, int ai, int wr, int wc, int fr, int fq, float sc_) const {
#pragma unroll
        for (int m = 0; m < 4; ++m) {
            const int row = u.pm * BM + ai * HALF + wr * 64 + m * 16 + fr;
            float ss = 0.f;
#pragma unroll
            for (int bj = 0; bj < 2; ++bj) {
                const size_t off = (size_t)row * 1024 + u.pn * BM + bj * HALF + wc * 32 + 8 * fq;
                const f32x4 x0 = bv[m][bj][0] + acc[ai][bj][m][0] * sc_, x1 = bv[m][bj][1] + acc[ai][bj][m][1] * sc_;
                u32x4 w; w.x = pk2(x0[0], x0[1]); w.y = pk2(x0[2], x0[3]); w.z = pk2(x1[0], x1[1]); w.w = pk2(x1[2], x1[3]);
                *(u32x4*)(xb + off) = w;
                ss += (x0[0] * x0[0] + x0[1] * x0[1]) + (x0[2] * x0[2] + x0[3] * x0[3]) + (x1[0] * x1[0] + x1[1] * x1[1]) + (x1[2] * x1[2] + x1[3] * x1[3]);
            }
            ss += shx<16>(ss); ss = xsum32(ss);
            if (fq == 0) part[(size_t)row * 16 + u.pn * 4 + wc] = ss;
        }
    }
    __device__ __forceinline__ void operator()(const f32x4 (&acc)[2][2][4][2], const Unit& u, int wr, int wc, int fr, int fq, const LAS float*) const {
        const float sc_ = dry ? 0.f : scale;
        asm volatile("" : "+v"(fr), "+v"(fq), "+v"(wc), "+v"(wr));
        if (base32) {
#pragma unroll
            for (int ai = 0; ai < 2; ++ai) {
                f32x4 bv[4][2][2];
#pragma unroll
                for (int m = 0; m < 4; ++m)
#pragma unroll
                    for (int bj = 0; bj < 2; ++bj) {
                        const size_t off = (size_t)(u.pm * BM + ai * HALF + wr * 64 + m * 16 + fr) * 1024 + u.pn * BM + bj * HALF + wc * 32 + 8 * fq;
                        bv[m][bj][0] = *(const f32x4*)(base32 + off); bv[m][bj][1] = *(const f32x4*)(base32 + off + 4);
                    }
                asm volatile("" ::: "memory");
                finish(acc, bv, u, ai, wr, wc, fr, fq, sc_);
                asm volatile("" ::: "memory");
            }
        } else {
            u32x4 raw[2][4][2];
#pragma unroll
            for (int ai = 0; ai < 2; ++ai)
#pragma unroll
                for (int m = 0; m < 4; ++m)
#pragma unroll
                    for (int bj = 0; bj < 2; ++bj) {
                        const size_t off = (size_t)(u.pm * BM + ai * HALF + wr * 64 + m * 16 + fr) * 1024 + u.pn * BM + bj * HALF + wc * 32 + 8 * fq;
                        raw[ai][m][bj] = *(const u32x4*)(xb + off);
                    }
            asm volatile("" ::: "memory");
#pragma unroll
            for (int ai = 0; ai < 2; ++ai) {
                f32x4 bv[4][2][2];
#pragma unroll
                for (int m = 0; m < 4; ++m)
#pragma unroll
                    for (int bj = 0; bj < 2; ++bj) {
                        bv[m][bj][0] = (f32x4){bflo(raw[ai][m][bj][0]), bfhi(raw[ai][m][bj][0]), bflo(raw[ai][m][bj][1]), bfhi(raw[ai][m][bj][1])};
                        bv[m][bj][1] = (f32x4){bflo(raw[ai][m][bj][2]), bfhi(raw[ai][m][bj][2]), bflo(raw[ai][m][bj][3]), bfhi(raw[ai][m][bj][3])};
                    }
                finish(acc, bv, u, ai, wr, wc, fr, fq, sc_);
            }
            asm volatile("" ::: "memory");
        }
    }
};
struct EpiScale {
    static constexpr bool PERM = true, AFTER_DRAIN = false, RSTD = true;
    bf16_t* O; int ldc; size_t plane; const float* part; float scale; float* Of; int f32_from;
    __device__ __forceinline__ void rstd_issue(const Unit& u, int tid, f32x4& r0, f32x4& r1) const { if (part) rstd_issue_(part, u.pm * BM, tid, r0, r1); }
    __device__ __forceinline__ void rstd_finish(LAS float* dst, int tid, const f32x4& r0, const f32x4& r1) const { if (part) rstd_finish_(dst, tid, r0, r1); }
    __device__ __forceinline__ void operator()(const f32x4 (&acc)[2][2][4][2], const Unit& u, int wr, int wc, int fr, int fq, const LAS float* rsl) const {
        float rs[2][4];
        if (part) read_rstd(rsl, wr, fr, rs);
        else {
#pragma unroll
            for (int ai = 0; ai < 2; ++ai)
#pragma unroll
                for (int m = 0; m < 4; ++m) rs[ai][m] = 1.f;
        }
        const bool tof32 = u.pn >= f32_from;
        bf16_t* dst = O + (size_t)u.pn * plane + (plane ? 0 : u.pn * BM);
#pragma unroll
        for (int ai = 0; ai < 2; ++ai)
#pragma unroll
            for (int m = 0; m < 4; ++m) {
                const int row = u.pm * BM + ai * HALF + wr * 64 + m * 16 + fr; const float r = rs[ai][m] * scale;
#pragma unroll
                for (int bj = 0; bj < 2; ++bj) {
                    const int col = bj * HALF + wc * 32 + 8 * fq;
                    const f32x4 v0 = acc[ai][bj][m][0] * r, v1 = acc[ai][bj][m][1] * r;
                    if (tof32) { float* p = Of + (size_t)row * 256 + col; *(f32x4*)p = v0; *(f32x4*)(p + 4) = v1; }
                    else { u32x4 w; w.x = pk2(v0[0], v0[1]); w.y = pk2(v0[2], v0[3]); w.z = pk2(v1[0], v1[1]); w.w = pk2(v1[2], v1[3]);
                        *(u32x4*)(dst + (size_t)row * ldc + col) = w; }
                }
            }
    }
};

template <class Epi, class Sched, bool ALIGN_EPI = false, bool SP2 = false>
__device__ __forceinline__ void gemm_phase(PG8_LAS unsigned char* lds, const Gemm g, const Sched& S, const Epi& E, const int tid) {
    const int  wid = __builtin_amdgcn_readfirstlane(tid >> 6), lane = tid & 63, wr = wid >> 2, wc = wid & 3, fr = lane & 15, fq = lane >> 4;
    const int K = g.K, nt = K / BK;
    unsigned voffA[2], voffB[2];
#pragma unroll
    for (int i = 0; i < 2; ++i) { int R, C; stage_rc(tid * 16 + i * 8192, R, C); const int Rb = Epi::PERM ? ((R & ~31) + perm32(R & 31)) : R;
        voffA[i] = (unsigned)(R * K + C) * 2u; voffB[i] = (unsigned)(Rb * K + C) * 2u; }
    const size_t kstep = (size_t)(BK * 2);
    const size_t hstep = (size_t)HALF * K * 2;
    const size_t tstep = 2 * hstep;
    const unsigned ldsw = (unsigned)wid * 1024u;
    const int aoff = lds_byte(wr * 64 + fr, fq * 8), boff = lds_byte(wc * 32 + fr, fq * 8);
#define PG8_SA(b, h) (((b) * 2 + (h)) * HTB)
#define PG8_SB(b, h) ((4 + (b) * 2 + (h)) * HTB)
#define PG8_STAGE(bufoff, gbase, voff) do { _Pragma("unroll") for (int _i = 0; _i < 2; ++_i) \
        __builtin_amdgcn_global_load_lds((const unsigned*)((const char*)(gbase) + (voff)[_i]), (PG8_LAS unsigned*)(lds + (bufoff) + ldsw + _i * 8192), 16, 0, 0); } while (0)
#define PG8_LDA(dst, b, h) do { _Pragma("unroll") for (int m = 0; m < 4; ++m) _Pragma("unroll") for (int k = 0; k < 2; ++k) dst[m][k] = *(const PG8_LAS bf16x8*)(lds + PG8_SA(b, h) + aoff + m * 2048 + k * 1024); } while (0)
#define PG8_LDB(dst, b, h) do { _Pragma("unroll") for (int n = 0; n < 2; ++n) _Pragma("unroll") for (int k = 0; k < 2; ++k) dst[n][k] = *(const PG8_LAS bf16x8*)(lds + PG8_SB(b, h) + boff + n * 2048 + k * 1024); } while (0)
#define PG8_MMA(ai, bj, At, Bt) do { __builtin_amdgcn_s_setprio(1); _Pragma("unroll") for (int m = 0; m < 4; ++m) _Pragma("unroll") for (int n = 0; n < 2; ++n) _Pragma("unroll") for (int k = 0; k < 2; ++k) \
        acc[ai][bj][m][n] = __builtin_amdgcn_mfma_f32_16x16x32_bf16(Bt[n][k], At[m][k], acc[ai][bj][m][n], 0, 0, 0); __builtin_amdgcn_s_setprio(0); } while (0)
#define PG8_WAIT_V(n) asm volatile("s_waitcnt vmcnt(" #n ")" ::: "memory")
#define PG8_WAIT_L(n) asm volatile("s_waitcnt lgkmcnt(" #n ")" ::: "memory")
#define PG8_BAR __builtin_amdgcn_s_barrier()
#define PG8_SCHED __builtin_amdgcn_sched_barrier(0)
    Unit cur, nxt; int ui = 0;
    if (!S.next(0, cur)) return;
    f32x4 acc[2][2][4][2];
#pragma unroll
    for (int a = 0; a < 2; ++a)
#pragma unroll
        for (int b = 0; b < 2; ++b)
#pragma unroll
            for (int m = 0; m < 4; ++m)
#pragma unroll
                for (int n = 0; n < 2; ++n) acc[a][b][m][n] = (f32x4){0.f, 0.f, 0.f, 0.f};
    bf16x8 At[4][2], B0[2][2], B1[2][2];
    const char* cA = (const char*)g.A + (size_t)cur.pm * tstep; const char* cB = (const char*)g.Bt + (size_t)cur.pn * tstep;
    S.a_ready(cur);
    PG8_LAS float* const rsl = (PG8_LAS float*)(lds + STAGE_BYTES);
    if constexpr (Epi::RSTD) { f32x4 r0_, r1_; E.rstd_issue(cur, tid, r0_, r1_); E.rstd_finish(rsl, tid, r0_, r1_); }
    if constexpr (SP2) {
        PG8_STAGE(PG8_SB(0, 0), cB, voffB); PG8_STAGE(PG8_SB(0, 1), cB + hstep, voffB); PG8_STAGE(PG8_SA(0, 0), cA, voffA); PG8_STAGE(PG8_SA(0, 1), cA + hstep, voffA);
        if (wr == 1) PG8_BAR;
        PG8_WAIT_V(2); PG8_BAR;
        PG8_STAGE(PG8_SB(1, 0), cB + kstep, voffB); PG8_STAGE(PG8_SA(1, 0), cA + kstep, voffA); PG8_STAGE(PG8_SB(1, 1), cB + hstep + kstep, voffB);
        PG8_WAIT_V(6); PG8_BAR;
    } else {
        PG8_STAGE(PG8_SB(0, 0), cB, voffB); PG8_STAGE(PG8_SA(0, 0), cA, voffA); PG8_STAGE(PG8_SB(0, 1), cB + hstep, voffB); PG8_STAGE(PG8_SA(0, 1), cA + hstep, voffA);
        if (wr == 1) PG8_BAR;
        PG8_WAIT_V(4); PG8_BAR;
        PG8_STAGE(PG8_SB(1, 0), cB + kstep, voffB); PG8_STAGE(PG8_SA(1, 0), cA + kstep, voffA); PG8_STAGE(PG8_SB(1, 1), cB + hstep + kstep, voffB);
        PG8_WAIT_V(6); PG8_BAR;
    }
    for (;;) {
        const bool has_next = S.next(ui + 1, nxt);
        const char* nA = has_next ? (const char*)g.A + (size_t)nxt.pm * tstep : cA; const char* nB = has_next ? (const char*)g.Bt + (size_t)nxt.pn * tstep : cB;
        for (int t = 0; t < nt; t += 2) {
            const bool last = (t == nt - 2);
            const char* a1 = cA + (size_t)(t + 1) * kstep;
            const char* a2 = last ? nA : cA + (size_t)(t + 2) * kstep; const char* b2 = last ? nB : cB + (size_t)(t + 2) * kstep;
            const char* a3 = a2 + kstep; const char* b3 = b2 + kstep;
            if (last && has_next) S.a_ready(nxt);
            if constexpr (SP2) {
            PG8_LDB(B0, 0, 0); PG8_LDB(B1, 0, 1); PG8_SCHED; PG8_LDA(At, 0, 0); PG8_STAGE(PG8_SA(1, 1), a1 + hstep, voffA);
            PG8_WAIT_V(8); PG8_WAIT_L(0); PG8_BAR; PG8_MMA(0, 0, At, B0); PG8_MMA(0, 1, At, B1); PG8_BAR; PG8_SCHED;
            PG8_LDA(At, 0, 1); PG8_STAGE(PG8_SB(0, 0), b2, voffB); PG8_STAGE(PG8_SB(0, 1), b2 + hstep, voffB); PG8_STAGE(PG8_SA(0, 0), a2, voffA);
            PG8_WAIT_V(8); PG8_WAIT_L(0); PG8_BAR; PG8_MMA(1, 0, At, B0); PG8_MMA(1, 1, At, B1); PG8_BAR; PG8_SCHED;
            PG8_LDB(B0, 1, 0); PG8_LDB(B1, 1, 1); PG8_SCHED; PG8_LDA(At, 1, 0); PG8_STAGE(PG8_SA(0, 1), a2 + hstep, voffA);
            PG8_WAIT_V(8); PG8_WAIT_L(0); PG8_BAR; PG8_MMA(0, 0, At, B0); PG8_MMA(0, 1, At, B1); PG8_BAR; PG8_SCHED;
            PG8_LDA(At, 1, 1); PG8_STAGE(PG8_SB(1, 0), b3, voffB); PG8_STAGE(PG8_SB(1, 1), b3 + hstep, voffB); PG8_STAGE(PG8_SA(1, 0), a3, voffA);
            PG8_WAIT_V(8); PG8_WAIT_L(0); PG8_BAR; PG8_MMA(1, 0, At, B0); PG8_MMA(1, 1, At, B1); PG8_BAR; PG8_SCHED;
            } else {
            PG8_LDB(B0, 0, 0); PG8_SCHED; PG8_LDA(At, 0, 0); PG8_STAGE(PG8_SA(1, 1), a1 + hstep, voffA);
            PG8_WAIT_L(8); PG8_BAR; PG8_WAIT_L(0); PG8_MMA(0, 0, At, B0); PG8_BAR; PG8_SCHED;
            PG8_LDB(B1, 0, 1); PG8_STAGE(PG8_SB(0, 0), b2, voffB);
            PG8_BAR; PG8_WAIT_L(0); PG8_MMA(0, 1, At, B1); PG8_BAR;
            PG8_LDA(At, 0, 1); PG8_STAGE(PG8_SA(0, 0), a2, voffA);
            PG8_BAR; PG8_WAIT_L(0); PG8_MMA(1, 0, At, B0); PG8_BAR; PG8_SCHED;
            PG8_STAGE(PG8_SB(0, 1), b2 + hstep, voffB);
            PG8_WAIT_V(6); PG8_BAR; PG8_MMA(1, 1, At, B1); PG8_BAR;
            PG8_LDB(B0, 1, 0); PG8_SCHED; PG8_LDA(At, 1, 0); PG8_STAGE(PG8_SA(0, 1), a2 + hstep, voffA);
            PG8_WAIT_L(8); PG8_BAR; PG8_WAIT_L(0); PG8_MMA(0, 0, At, B0); PG8_BAR; PG8_SCHED;
            PG8_LDB(B1, 1, 1); PG8_STAGE(PG8_SB(1, 0), b3, voffB);
            PG8_BAR; PG8_WAIT_L(0); PG8_MMA(0, 1, At, B1); PG8_BAR;
            PG8_LDA(At, 1, 1); PG8_STAGE(PG8_SA(1, 0), a3, voffA);
            PG8_BAR; PG8_WAIT_L(0); PG8_MMA(1, 0, At, B0); PG8_BAR; PG8_SCHED;
            PG8_STAGE(PG8_SB(1, 1), b3 + hstep, voffB);
            PG8_WAIT_V(6); PG8_BAR; PG8_MMA(1, 1, At, B1); PG8_BAR;
            }
        }
        if constexpr (ALIGN_EPI) { if (wr == 0) PG8_BAR; }
        if constexpr (!Epi::AFTER_DRAIN) {
            f32x4 r0_, r1_;
            if constexpr (Epi::RSTD) { if (has_next) E.rstd_issue(nxt, tid, r0_, r1_); }
            E(acc, cur, wr, wc, fr, fq, rsl + (ui & 1) * 256);
            if constexpr (Epi::RSTD) { if (has_next) E.rstd_finish(rsl + ((ui + 1) & 1) * 256, tid, r0_, r1_); }
            S.done(cur); }
        if (!has_next) break;
#pragma unroll
        for (int a = 0; a < 2; ++a)
#pragma unroll
            for (int b = 0; b < 2; ++b)
#pragma unroll
                for (int m = 0; m < 4; ++m)
#pragma unroll
                    for (int n = 0; n < 2; ++n) acc[a][b][m][n] = (f32x4){0.f, 0.f, 0.f, 0.f};
        cur = nxt; cA = nA; cB = nB; ++ui;
        if constexpr (ALIGN_EPI) { if (wr == 1) PG8_BAR; }
    }
    PG8_WAIT_V(0);
    if constexpr (!ALIGN_EPI) { if (wr == 0) PG8_BAR; }
    PG8_BAR;
    if constexpr (Epi::AFTER_DRAIN) { E.fused(acc, cur, wr, wc, fr, fq, lds, wid, lane); S.done(cur); }
#undef PG8_SA
#undef PG8_SB
#undef PG8_STAGE
#undef PG8_LDA
#undef PG8_LDB
#undef PG8_MMA
#undef PG8_WAIT_V
#undef PG8_WAIT_L
#undef PG8_BAR
#undef PG8_SCHED
}
}

#define GAS __attribute__((address_space(1)))
typedef GAS unsigned gu32;
#define XB_TMO      128
#define XB_XCNT(j)  (256  + 64 * (j))
#define XB_XSUB(j)  (1280 + 64 * (j))
#define XB_XGEN(j)  (2304 + 64 * (j))
#define XB_TOP      3328
#define XB_TOPGEN   3392
#define XCD_BAR_WORDS 3456
#define XB_SPIN_CAP (1u << 18)

__device__ __forceinline__ unsigned xb_ld(unsigned* p)              { return __hip_atomic_load(p, __ATOMIC_RELAXED, __HIP_MEMORY_SCOPE_AGENT); }
__device__ __forceinline__ unsigned xb_add(unsigned* p, unsigned v) { return __hip_atomic_fetch_add(p, v, __ATOMIC_RELAXED, __HIP_MEMORY_SCOPE_AGENT); }
__device__ __forceinline__ unsigned xb_xcc_id() { return (unsigned)__builtin_amdgcn_s_getreg((3 << 11) | 20) & 0xFu; }
#define XB_SPIN(cond, bar) do { unsigned _sp = 0; while (cond) { __builtin_amdgcn_s_sleep(1); \
    if ((++_sp & 255u) == 0u) { if (xb_ld(&(bar)[XB_TMO])) break; if (_sp > XB_SPIN_CAP) { atomicAdd(&(bar)[XB_TMO], 1u); break; } } } } while (0)

struct XcdBarrier {
    unsigned* bar; unsigned x;
    volatile LAS unsigned* st;
};

__device__ __forceinline__ XcdBarrier xcd_barrier_post(unsigned* bar, volatile LAS unsigned* st) {
    XcdBarrier b; b.bar = bar; b.x = xb_xcc_id(); b.st = st;
    if (threadIdx.x == 0) (void)xb_add(&bar[XB_XCNT(b.x)], 1u);
    return b;
}
__device__ __forceinline__ void xcd_barrier_complete(unsigned* bar, unsigned x, unsigned& nloc, unsigned& nx) {
    const unsigned G = gridDim.x * gridDim.y * gridDim.z;
    unsigned sum, cnt, mine, sp = 0u;
    for (;;) {
        sum = 0u; cnt = 0u; mine = 0u;
#pragma unroll
        for (unsigned j = 0; j < 16; ++j) { const unsigned c = xb_ld(&bar[XB_XCNT(j)]); sum += c; cnt += (c > 0u) ? 1u : 0u; mine = (j == x) ? c : mine; }
        if (sum == G) break;
        __builtin_amdgcn_s_sleep(1);
        if ((++sp & 255u) == 0u) { if (xb_ld(&bar[XB_TMO])) break; if (sp > XB_SPIN_CAP) { atomicAdd(&bar[XB_TMO], 1u); break; } }
    }
    nloc = mine > 0u ? mine : 1u; nx = cnt > 0u ? cnt : 1u;
}

__device__ __forceinline__ void xcd_barrier_a(const XcdBarrier& b, const int tid_) {
    asm volatile("s_waitcnt vmcnt(0)" ::: "memory");
    __syncthreads();
}
__device__ __forceinline__ void xcd_barrier_b(const XcdBarrier& b, const int tid_) {
    if (tid_ == 0) {
        unsigned* bar = b.bar;
        __builtin_amdgcn_s_waitcnt(0);
        unsigned nloc = b.st[0], nx = b.st[1];
        if (nloc == 0u) { xcd_barrier_complete(bar, b.x, nloc, nx); b.st[0] = nloc; b.st[1] = nx; }
        const unsigned old = xb_add(&bar[XB_XSUB(b.x)], 1u);
        const unsigned gen = old / nloc;
        if (old + 1u == (gen + 1u) * nloc) {
            __builtin_amdgcn_fence(__ATOMIC_RELEASE, "agent");
            asm volatile("s_waitcnt vmcnt(0)" ::: "memory");
            const unsigned og = xb_add(&bar[XB_TOP], 1u);
            const unsigned tg = og / nx;
            if (og + 1u == (tg + 1u) * nx) xb_add(&bar[XB_TOPGEN], 1u);
            else XB_SPIN(xb_ld(&bar[XB_TOPGEN]) == tg, bar);
            __builtin_amdgcn_fence(__ATOMIC_ACQUIRE, "agent");
            xb_add(&bar[XB_XGEN(b.x)], 1u);
            asm volatile("s_waitcnt vmcnt(0)" ::: "memory");
        } else {
            XB_SPIN(xb_ld(&bar[XB_XGEN(b.x)]) == gen, bar);
            __builtin_amdgcn_fence(__ATOMIC_ACQUIRE, "agent");
            asm volatile("s_waitcnt vmcnt(0)" ::: "memory");
        }
    }
    __syncthreads();
}
__device__ __forceinline__ void xcd_barrier(const XcdBarrier& b, const int tid_) { xcd_barrier_a(b, tid_); xcd_barrier_b(b, tid_); }

constexpr size_t MiB = 1u << 20;
constexpr size_t WS_CTL = 0, CTL_BYTES = 1 * MiB;
constexpr size_t WS_SLOTA = 1 * MiB, WS_SLOTB = 12 * MiB;
constexpr size_t WS_WKV = 23 * MiB;
constexpr size_t WS_KMEM = 31 * MiB;
constexpr size_t WS_VMEMT = 33 * MiB;
constexpr size_t WS_MEMN = 35 * MiB;
constexpr size_t WS_ROPE = 37 * MiB;
constexpr size_t WS_PART = 38 * MiB;
constexpr size_t WS_XB = 40 * MiB;
constexpr size_t WS_BIG = 88 * MiB;
constexpr size_t WS_H = WS_BIG;
constexpr size_t WS_P = WS_BIG;
constexpr size_t WS_OBUF = WS_BIG;
constexpr size_t WS_PF = 176 * MiB;
constexpr size_t WS_Y = 192 * MiB;
constexpr size_t WS_KB = 224 * MiB;
constexpr size_t WS_VT = 232 * MiB;
constexpr size_t WS_IKB = 240 * MiB;
constexpr size_t WS_Q = WS_BIG, WS_O = WS_BIG + 32 * MiB;
constexpr size_t WS_END = 242 * MiB;
enum { PL_U = 0, PL_V, PL_B, PL_C, PL_H, PL_Q, PL_IQ, PL_GQ, PL_GK, PL_GV, PL_GG, PL_N };
constexpr int PF_CKV = 0, PF_IK = 128, PF_IW = 192, PF_GA = 196, PF_GB = 200;
constexpr int GR_W = 0, GR_QG = 8192, GR_ATT = 16384, GR_KGT = 24576, GR_U = 32768, GR_BYTES = 49152;
constexpr size_t WS_EG = 512 * 1024;
constexpr size_t WS_WUKV = 64 * 1024;
constexpr int TILE_BYTES = 36864, TR_IK = 0, TR_K = 4096, TR_V = 20480;
constexpr int CW_QCTR = 64;
static_assert((size_t)1024 * GR_BYTES <= (size_t)MTOK * DM * 4, "gdn records fit d_out");
constexpr int LDS_BYTES = 163840;

struct Params {
    const float* in[33];
    float* out; unsigned char* ws;
    int pad0, pad1;
};

struct Frame { LAS unsigned char* lds; unsigned char* ws; int tid, lane, wave, G, bid; };

struct ConvJob { const float* W; const float* W2; const float* gain; bf16_t* dst; int K, Nsrc, Ndst, mode; };
DI int mix_src_col(int n) {
    if (n < 1536) return n;
    if (n < 1792) return n - 1536 + 1664;
    if (n < 2560) return n - 1792 + 1988;
    if (n < 2816) return n - 2560 + 2764;
    if (n < 2944) return n - 2816 + 1536;
    if (n < 3008) return n - 2944 + 1920;
    if (n < 3012) return n - 3008 + 1984;
    if (n < 3016) return n - 3012 + 2756;
    if (n < 3020) return n - 3016 + 2760;
    return -1;
}
DI void conv_load(const ConvJob& J, int item, int lane, float (&v)[64], float& keep) {
    const int nblk = J.Ndst / 64, kb = item / nblk, nb = item % nblk, k0 = 64 * kb, n0 = 64 * nb;
    const int n = n0 + lane;
    const float* src = J.W; int col = n;
    if (J.mode == 1) { const int t = n >> 8, j = n & 255; src = (j < 128) ? J.W : J.W2; col = 128 * t + (j & 127); }
    else if (J.mode == 2) { col = mix_src_col(n); }
    keep = col >= 0 ? 1.f : 0.f; col = col >= 0 ? col : 0;
    const float* sp = src + (size_t)k0 * J.Nsrc + col;
#pragma unroll
    for (int kk = 0; kk < 64; ++kk) v[kk] = sp[(size_t)kk * J.Nsrc];
}
template <bool GAIN>
DI void conv_finish(const ConvJob& J, LAS unsigned* scr, int item, int lane, const float (&v)[64], float keep) {
    const int nblk = J.Ndst / 64, kb = item / nblk, nb = item % nblk, k0 = 64 * kb, n0 = 64 * nb;
#pragma unroll
    for (int kk = 0; kk < 64; kk += 2) {
        float a0 = v[kk] * keep, a1 = v[kk + 1] * keep;
        if (GAIN) { a0 *= J.gain[k0 + kk]; a1 *= J.gain[k0 + kk + 1]; }
        scr[lane * 33 + (kk >> 1)] = pk2(a0, a1);
    }
    asm volatile("s_waitcnt lgkmcnt(0)" ::: "memory");
    const int c = lane & 7, rg = lane >> 3;
    u32x4 o[8];
#pragma unroll
    for (int j = 0; j < 8; ++j) { const int row = rg + 8 * j; const LAS unsigned* q = scr + row * 33 + 4 * c; o[j].x = q[0]; o[j].y = q[1]; o[j].z = q[2]; o[j].w = q[3]; }
    __builtin_amdgcn_sched_barrier(0);
#pragma unroll
    for (int j = 0; j < 8; ++j) { const int row = rg + 8 * j; *(u32x4*)(J.dst + (size_t)(n0 + row) * J.K + k0 + 8 * c) = o[j]; }
    asm volatile("s_waitcnt lgkmcnt(0)" ::: "memory");
}
template <bool GAIN>
DI void conv_item(const ConvJob& J, LAS unsigned* scr, int item, int lane) {
    float v[64], keep; conv_load(J, item, lane, v, keep); conv_finish<GAIN>(J, scr, item, lane, v, keep);
}
DI void conv_run(Frame& F, const ConvJob& J) {
    LAS unsigned* scr = (LAS unsigned*)(F.lds + F.wave * 16384);
    const int gw = F.bid * 8 + F.wave, NGW = F.G * 8, NITEMS = (J.K / 64) * (J.Ndst / 64);
    if (J.gain) { for (int it = gw; it < NITEMS; it += NGW) conv_item<true>(J, scr, it, F.lane); }
    else { for (int it = gw; it < NITEMS; it += NGW) conv_item<false>(J, scr, it, F.lane); }
}
DI bf16_t* slot_of(Frame& F, int id) { return (bf16_t*)(F.ws + ((id & 1) ? WS_SLOTB : WS_SLOTA)); }
DI ConvJob conv_job(Frame& F, const Params& p, int layer, int id) {
    ConvJob J; J.W2 = nullptr; J.gain = nullptr; J.dst = slot_of(F, id); J.mode = 0;
    switch (id) {
    case 0: J.W = p.in[4] + (size_t)layer * DM * FF; J.W2 = p.in[5] + (size_t)layer * DM * FF; J.gain = p.in[3] + layer * DM; J.K = DM; J.Nsrc = FF; J.Ndst = 2 * FF; J.mode = 1; break;
    case 1: J.W = p.in[6] + (size_t)layer * FF * DM; J.K = FF; J.Nsrc = DM; J.Ndst = DM; break;
    case 2: J.W = p.in[8] + (size_t)layer * DM * NMIX; J.gain = p.in[7] + layer * DM; J.K = DM; J.Nsrc = NMIX; J.Ndst = NMIXP; J.mode = 2; break;
    case 3: J.W = p.in[9] + (size_t)layer * DM * DM; J.K = DM; J.Nsrc = DM; J.Ndst = DM; break;
    case 4: J.W = p.in[24] + (size_t)layer * DM * DM; J.gain = p.in[22] + layer * DM; J.K = DM; J.Nsrc = DM; J.Ndst = DM; break;
    case 5: J.W = p.in[27] + (size_t)layer * DM * DM; J.K = DM; J.Nsrc = DM; J.Ndst = DM; break;
    case 6: J.W = p.in[29] + (size_t)layer * DM * FF; J.W2 = p.in[30] + (size_t)layer * DM * FF; J.gain = p.in[28] + layer * DM; J.K = DM; J.Nsrc = FF; J.Ndst = 2 * FF; J.mode = 1; break;
    default: J.W = p.in[31] + (size_t)layer * FF * DM; J.K = FF; J.Nsrc = DM; J.Ndst = DM; break;
    }
    return J;
}
DI void conv_for(Frame& F, const Params& p, int layer, int id) { const ConvJob J = conv_job(F, p, layer, id); conv_run(F, J); }

DI void prologue(Frame& F, const Params& p) {
    const int gw = F.bid * 8 + F.wave, NGW = F.G * 8, lane = F.lane;
    for (int l = 0; l < DEPTH; ++l) {
        ConvJob J; J.W2 = nullptr; J.gain = nullptr; J.mode = 0; J.K = DM; J.Nsrc = DM; J.Ndst = DM;
        J.W = p.in[25] + (size_t)l * DM * DM; J.dst = (bf16_t*)(F.ws + WS_WKV) + (size_t)(2 * l) * DM * DM; conv_run(F, J);
        J.W = p.in[26] + (size_t)l * DM * DM; J.dst = (bf16_t*)(F.ws + WS_WKV) + (size_t)(2 * l + 1) * DM * DM; conv_run(F, J);
    }
    for (int l = 0; l < DEPTH; ++l) {
        ConvJob J; J.W2 = nullptr; J.gain = p.in[14] + l * 128; J.mode = 0; J.K = 128; J.Nsrc = 256; J.Ndst = 256;
        J.W = p.in[15] + (size_t)l * 128 * 256; J.dst = (bf16_t*)(F.ws + WS_WUKV) + (size_t)(2 * l) * 256 * 128; conv_run(F, J);
        J.W = p.in[16] + (size_t)l * 128 * 256; J.dst = (bf16_t*)(F.ws + WS_WUKV) + (size_t)(2 * l + 1) * 256 * 128; conv_run(F, J);
    }
    conv_for(F, p, 0, 0);
    const float* x = p.in[0]; bf16_t* xb = (bf16_t*)(F.ws + WS_XB); float* part = (float*)(F.ws + WS_PART);
    for (int m0 = gw; m0 < MTOK; m0 += 2 * NGW) {
        f32x4 v[2][4];
#pragma unroll
        for (int k = 0; k < 2; ++k) { const f32x4* xr = (const f32x4*)(x + (size_t)(m0 + k * NGW) * DM) + lane;
#pragma unroll
            for (int j = 0; j < 4; ++j) v[k][j] = xr[64 * j]; }
        asm volatile("" ::: "memory");
#pragma unroll
        for (int k = 0; k < 2; ++k) { const int m = m0 + k * NGW; float s = 0.f;
            u32x2* o = (u32x2*)(xb + (size_t)m * DM) + lane;
#pragma unroll
            for (int j = 0; j < 4; ++j) { const f32x4 vv = v[k][j]; s += (vv[0] * vv[0] + vv[1] * vv[1]) + (vv[2] * vv[2] + vv[3] * vv[3]); u32x2 w; w.x = pk2(vv[0], vv[1]); w.y = pk2(vv[2], vv[3]); o[64 * j] = w; }
            s = wave_sum(s);
            if (lane < 16) part[(size_t)m * 16 + lane] = (lane == 0) ? s : 0.f; }
    }
    const float* mem = p.in[1];
    for (int r = gw; r < DEPTH * MEMROWS; r += NGW) {
        const int l = r / MEMROWS, m = r % MEMROWS;
        const f32x4* xr = (const f32x4*)(mem + (size_t)m * DM) + lane; const f32x4* gr = (const f32x4*)(p.in[23] + l * DM) + lane;
        f32x4 v[4]; float s = 0.f;
#pragma unroll
        for (int j = 0; j < 4; ++j) { v[j] = xr[64 * j]; s += (v[j][0] * v[j][0] + v[j][1] * v[j][1]) + (v[j][2] * v[j][2] + v[j][3] * v[j][3]); }
        const float rstd = rsqrtf(wave_sum(s) * (1.f / DM) + EPS);
        u32x2* o = (u32x2*)((bf16_t*)(F.ws + WS_MEMN) + ((size_t)l * MEMROWS + m) * DM) + lane;
#pragma unroll
        for (int j = 0; j < 4; ++j) { const f32x4 g = gr[64 * j]; u32x2 w; w.x = pk2(v[j][0] * rstd * g[0], v[j][1] * rstd * g[1]); w.y = pk2(v[j][2] * rstd * g[2], v[j][3] * rstd * g[3]); o[64 * j] = w; }
    }
    const int* pos = (const int*)p.in[2]; float* rope = (float*)(F.ws + WS_ROPE);
    for (int i = F.bid * 512 + F.tid; i < MTOK * 8; i += F.G * 512) {
        const int m = i >> 3, k = i & 7;
        const float inv = exp2f(-(float)k * 0.125f * 18.931568569324174f);
        const float ang = (float)pos[m] * inv; double rr = (double)ang; rr -= 6.283185307179586 * rint(rr * 0.15915494309189535);
        const float sn = sinf((float)rr), cs = cosf((float)rr);
        rope[(size_t)m * 16 + k] = cs; rope[(size_t)m * 16 + 8 + k] = sn;
    }
}

DI const bf16_t* plane(Frame& F, int pl) { return (const bf16_t*)(F.ws + WS_P) + (size_t)pl * MTOK * 256; }
DI int crow(int i, int h) { return (i & 3) + 8 * (i >> 2) + 4 * h; }
#define MFMA32(a, b, c) __builtin_amdgcn_mfma_f32_32x32x16_bf16((a), (b), (c), 0, 0, 0)
DI bf16x8 pack8(const f32x16& x, int s) {
    u32x4 p; p.x = pk2(x[8 * s + 0], x[8 * s + 1]); p.y = pk2(x[8 * s + 2], x[8 * s + 3]); p.z = pk2(x[8 * s + 4], x[8 * s + 5]); p.w = pk2(x[8 * s + 6], x[8 * s + 7]);
    return __builtin_bit_cast(bf16x8, p);
}

DI void sg_item(Frame& F, const Params& p, int layer, int c, int hd) {
    LAS bf16_t* Wb = (LAS bf16_t*)F.lds;
    LAS bf16_t* vnT = (LAS bf16_t*)(F.lds + 34816);
    LAS float* rst = (LAS float*)(F.lds + 52224);
    LAS float* outT = (LAS float*)(F.lds + 53248);
    const bf16_t* Pu = plane(F, PL_U); const bf16_t* Pv = plane(F, PL_V);
    bf16_t* Y = (bf16_t*)(F.ws + WS_Y);
    int tid = F.tid; asm volatile("" : "+v"(tid));
    const int t0 = c * 128, lane = tid & 63, wave = F.wave, r = lane & 31, h = lane >> 5;
    const int tq = tid >> 2, qtr = tid & 3;
    {
        const float* Wg = p.in[11] + (size_t)((layer * 4 + hd) * 128) * 128;
        f32x4 wv[8];
#pragma unroll
        for (int k = 0; k < 8; ++k) { const int i = tid + 512 * k; wv[k] = *(const f32x4*)(Wg + (i >> 5) * 128 + (i & 31) * 4); }
#pragma unroll
        for (int k = 0; k < 8; ++k) { const int i = tid + 512 * k, t = i >> 5, s4 = (i & 31) * 4;
            u32x2 o; o.x = pk2(s4 <= t ? wv[k][0] : 0.f, s4 + 1 <= t ? wv[k][1] : 0.f); o.y = pk2(s4 + 2 <= t ? wv[k][2] : 0.f, s4 + 3 <= t ? wv[k][3] : 0.f);
            *(LAS u32x2*)(Wb + t * 136 + s4) = o; }
    }
    {
        const u32x4* src = (const u32x4*)(Pv + (size_t)(t0 + tq) * 256 + qtr * 64); float ss = 0.f;
        u32x4 raw[8];
#pragma unroll
        for (int i = 0; i < 8; ++i) raw[i] = src[i];
#pragma unroll
        for (int i = 0; i < 8; ++i)
#pragma unroll
            for (int e = 0; e < 4; ++e) { const float a = gelu_tanh(bflo(raw[i][e])), bb = gelu_tanh(bfhi(raw[i][e])); ss += a * a + bb * bb; }
        ss += shx<1>(ss); ss += shx<2>(ss);
        const float rs = rsqrtf(ss * (1.f / 256.f) + EPS);
        const u32x4* s2 = (const u32x4*)(Pv + (size_t)(t0 + tq) * 256 + 64 * hd + 16 * qtr); const u32x4 v0 = s2[0], v1 = s2[1];
        const float* gn = p.in[10] + layer * 256 + 64 * hd + 16 * qtr;
#pragma unroll
        for (int e = 0; e < 4; ++e) {
            vnT[(16 * qtr + 2 * e) * 136 + tq] = (bf16_t)(pk2(gelu_tanh(bflo(v0[e])) * rs * gn[2 * e], 0.f) & 0xffffu);
            vnT[(16 * qtr + 2 * e + 1) * 136 + tq] = (bf16_t)(pk2(gelu_tanh(bfhi(v0[e])) * rs * gn[2 * e + 1], 0.f) & 0xffffu);
            vnT[(16 * qtr + 8 + 2 * e) * 136 + tq] = (bf16_t)(pk2(gelu_tanh(bflo(v1[e])) * rs * gn[8 + 2 * e], 0.f) & 0xffffu);
            vnT[(16 * qtr + 8 + 2 * e + 1) * 136 + tq] = (bf16_t)(pk2(gelu_tanh(bfhi(v1[e])) * rs * gn[8 + 2 * e + 1], 0.f) & 0xffffu);
        }
    }
    __syncthreads();
    {
        const int ti = wave >> 1, dj = wave & 1;
        f32x16 acc;
#pragma unroll
        for (int i = 0; i < 16; ++i) acc[i] = 0.f;
        const LAS bf16_t* ap = Wb + (32 * ti + r) * 136 + 8 * h; const LAS bf16_t* bp = vnT + (32 * dj + r) * 136 + 8 * h;
        for (int ks = 0; ks < 2 * (ti + 1); ++ks) acc = MFMA32(*(const LAS bf16x8*)(ap + 16 * ks), *(const LAS bf16x8*)(bp + 16 * ks), acc);
#pragma unroll
        for (int i = 0; i < 16; ++i) outT[(32 * ti + crow(i, h)) * 68 + 32 * dj + r] = acc[i];
    }
    __syncthreads();
    {
        const u32x4* us = (const u32x4*)(Pu + (size_t)(t0 + tq) * 256 + 64 * hd + 16 * qtr); const u32x4 u0 = us[0], u1 = us[1];
        const float bs = p.in[12][(layer * 4 + hd) * 128 + tq];
        const LAS f32x4* mp = (const LAS f32x4*)(outT + tq * 68 + 16 * qtr);
        const f32x4 m0 = mp[0], m1 = mp[1], m2 = mp[2], m3 = mp[3];
        float y[16];
#pragma unroll
        for (int e = 0; e < 4; ++e) { y[2 * e] = gelu_tanh(bflo(u0[e])); y[2 * e + 1] = gelu_tanh(bfhi(u0[e])); y[8 + 2 * e] = gelu_tanh(bflo(u1[e])); y[8 + 2 * e + 1] = gelu_tanh(bfhi(u1[e])); }
#pragma unroll
        for (int e = 0; e < 4; ++e) { y[e] *= m0[e] + bs; y[4 + e] *= m1[e] + bs; y[8 + e] *= m2[e] + bs; y[12 + e] *= m3[e] + bs; }
        u32x4 w0, w1;
        w0.x = pk2(y[0], y[1]); w0.y = pk2(y[2], y[3]); w0.z = pk2(y[4], y[5]); w0.w = pk2(y[6], y[7]);
        w1.x = pk2(y[8], y[9]); w1.y = pk2(y[10], y[11]); w1.z = pk2(y[12], y[13]); w1.w = pk2(y[14], y[15]);
        u32x4* dst = (u32x4*)(Y + (size_t)(t0 + tq) * 1024 + 64 * hd + 16 * qtr);
        dst[0] = w0; dst[1] = w1;
    }
    __syncthreads();
}
DI void sc_item(Frame& F, const Params& p, int layer, int item) {
    const bf16_t* Pb = plane(F, PL_B); const bf16_t* Pc = plane(F, PL_C); const bf16_t* Ph = plane(F, PL_H);
    bf16_t* Y = (bf16_t*)(F.ws + WS_Y);
    int tid = F.tid; asm volatile("" : "+v"(tid));
    const int cgp = tid & 31, run = tid >> 5, ch0 = 8 * cgp, tr = item * 64 + 4 * run, bstart = (tr / SEQ) * SEQ;
    const f32x4* wp = (const f32x4*)(p.in[13] + (size_t)layer * 256 * 3 + ch0 * 3);
    float wf[24];
#pragma unroll
    for (int k = 0; k < 6; ++k) { const f32x4 t4 = wp[k]; wf[4 * k] = t4[0]; wf[4 * k + 1] = t4[1]; wf[4 * k + 2] = t4[2]; wf[4 * k + 3] = t4[3]; }
    u32x4 c8[6], h8[6], b8[4];
#pragma unroll
    for (int k = 0; k < 6; ++k) { const int tok = tr - 2 + k; const int tc = tok >= bstart ? tok : bstart;
        c8[k] = *(const u32x4*)(Pc + (size_t)tc * 256 + ch0); h8[k] = *(const u32x4*)(Ph + (size_t)tc * 256 + ch0); }
#pragma unroll
    for (int t = 0; t < 4; ++t) b8[t] = *(const u32x4*)(Pb + (size_t)(tr + t) * 256 + ch0);
    float x[6][8];
#pragma unroll
    for (int k = 0; k < 6; ++k) { const float keep = (tr - 2 + k) >= bstart ? 1.f : 0.f;
#pragma unroll
        for (int e = 0; e < 4; ++e) { x[k][2 * e] = bflo(c8[k][e]) * bflo(h8[k][e]) * keep; x[k][2 * e + 1] = bfhi(c8[k][e]) * bfhi(h8[k][e]) * keep; } }
#pragma unroll
    for (int t = 0; t < 4; ++t) {
        float y[8];
#pragma unroll
        for (int e = 0; e < 8; ++e) { const float bb = (e & 1) ? bfhi(b8[t][e >> 1]) : bflo(b8[t][e >> 1]);
            y[e] = bb * (wf[3 * e] * x[t][e] + wf[3 * e + 1] * x[t + 1][e] + wf[3 * e + 2] * x[t + 2][e]); }
        u32x4 w; w.x = pk2(y[0], y[1]); w.y = pk2(y[2], y[3]); w.z = pk2(y[4], y[5]); w.w = pk2(y[6], y[7]);
        *(u32x4*)(Y + (size_t)(tr + t) * 1024 + 256 + ch0) = w;
    }
}
DI void dsa_prep_item(Frame& F, const Params& p, int layer, int item) {
    LAS bf16_t* cs = (LAS bf16_t*)F.lds;
    const float* Pf = (const float*)(F.ws + WS_PF); const float* rope = (const float*)(F.ws + WS_ROPE);
    int tid = F.tid; asm volatile("" : "+v"(tid));
    const int t0 = item * 64, lane = tid & 63, wave = F.wave, r = lane & 31, h = lane >> 5;
    unsigned char* rec0 = F.ws + WS_KB + (size_t)(2 * item) * TILE_BYTES;
    {
        const int t = tid >> 3, seg = tid & 7;
        const f32x4* src = (const f32x4*)(Pf + (size_t)(t0 + t) * 256 + PF_CKV + seg * 16);
        f32x4 v[4]; float s = 0.f;
#pragma unroll
        for (int i = 0; i < 4; ++i) { v[i] = src[i]; s += (v[i][0] * v[i][0] + v[i][1] * v[i][1]) + (v[i][2] * v[i][2] + v[i][3] * v[i][3]); }
        s += shx<1>(s); s += shx<2>(s); s += shx<4>(s);
        const float rr = rsqrtf(s * (1.f / 128.f) + EPS);
        u32x4 c0, c1;
        c0.x = pk2(v[0][0] * rr, v[0][1] * rr); c0.y = pk2(v[0][2] * rr, v[0][3] * rr); c0.z = pk2(v[1][0] * rr, v[1][1] * rr); c0.w = pk2(v[1][2] * rr, v[1][3] * rr);
        c1.x = pk2(v[2][0] * rr, v[2][1] * rr); c1.y = pk2(v[2][2] * rr, v[2][3] * rr); c1.z = pk2(v[3][0] * rr, v[3][1] * rr); c1.w = pk2(v[3][2] * rr, v[3][3] * rr);
        *(LAS u32x4*)(cs + t * 136 + seg * 16) = c0; *(LAS u32x4*)(cs + t * 136 + seg * 16 + 8) = c1;
        const f32x4* s2 = (const f32x4*)(Pf + (size_t)(t0 + t) * 256 + PF_IK + seg * 8);
        const f32x4 a0 = s2[0], a1 = s2[1];
        float q = (a0[0] * a0[0] + a0[1] * a0[1]) + (a0[2] * a0[2] + a0[3] * a0[3]) + (a1[0] * a1[0] + a1[1] * a1[1]) + (a1[2] * a1[2] + a1[3] * a1[3]);
        q += shx<1>(q); q += shx<2>(q); q += shx<4>(q);
        const float r2 = rsqrtf(q * (1.f / 64.f) + EPS); const float* g2 = p.in[17] + layer * 64 + seg * 8;
        float x[8];
#pragma unroll
        for (int e = 0; e < 4; ++e) { x[e] = a0[e] * r2 * g2[e]; x[4 + e] = a1[e] * r2 * g2[4 + e]; }
        const float* rp = rope + (size_t)(t0 + t) * 16;
#pragma unroll
        for (int e = 0; e < 8; ++e) { const float o = shx<1>(x[e]); const float cv = rp[e], sv = rp[8 + e];
            if (seg == 0) x[e] = x[e] * cv - o * sv; else if (seg == 1) x[e] = x[e] * cv + o * sv; }
        u32x4 w; w.x = pk2(x[0], x[1]); w.y = pk2(x[2], x[3]); w.z = pk2(x[4], x[5]); w.w = pk2(x[6], x[7]);
        *(u32x4*)(rec0 + (size_t)(t >> 5) * TILE_BYTES + TR_IK + (((seg >> 1) * 64) + (seg & 1) * 32 + (t & 31)) * 16) = w;
    }
    __syncthreads();
    const bf16_t* WukT = (const bf16_t*)(F.ws + WS_WUKV) + (size_t)(2 * layer) * 256 * 128; const bf16_t* WuvT = WukT + 256 * 128;
    f32x16 KT[2], VV[2];
#pragma unroll
    for (int tt = 0; tt < 2; ++tt)
#pragma unroll
        for (int i = 0; i < 16; ++i) { KT[tt][i] = 0.f; VV[tt][i] = 0.f; }
    bf16x8 wkf[8], wvf[8];
#pragma unroll
    for (int k8 = 0; k8 < 8; ++k8) { wkf[k8] = *(const bf16x8*)(WukT + (size_t)(32 * wave + r) * 128 + 16 * k8 + 8 * h); wvf[k8] = *(const bf16x8*)(WuvT + (size_t)(32 * wave + r) * 128 + 16 * k8 + 8 * h); }
    __builtin_amdgcn_sched_barrier(0);
#pragma unroll
    for (int k8 = 0; k8 < 8; ++k8) {
#pragma unroll
        for (int tt = 0; tt < 2; ++tt) {
            const bf16x8 cf = *(const LAS bf16x8*)(cs + (32 * tt + r) * 136 + 16 * k8 + 8 * h);
            KT[tt] = MFMA32(wkf[k8], cf, KT[tt]);
            VV[tt] = MFMA32(cf, wvf[k8], VV[tt]);
        }
    }
    const int hd = wave >> 1, half = wave & 1;
#pragma unroll
    for (int tt = 0; tt < 2; ++tt) {
        unsigned char* rec = rec0 + (size_t)tt * TILE_BYTES;
        if (half == 0) {
            const float* rp = rope + (size_t)(t0 + 32 * tt + r) * 16 + 4 * h;
#pragma unroll
            for (int i = 0; i < 4; ++i) { const float cv = rp[i], sv = rp[8 + i], x1 = KT[tt][i], x2 = KT[tt][i + 4]; KT[tt][i] = x1 * cv - x2 * sv; KT[tt][i + 4] = x2 * cv + x1 * sv; }
        }
#pragma unroll
        for (int s = 0; s < 2; ++s) {
            *(bf16x8*)(rec + TR_K + ((hd * 4 + 2 * half + s) * 64 + lane) * 16) = pack8(KT[tt], s);
            *(bf16x8*)(rec + TR_V + (((hd * 2 + half) * 2 + s) * 64 + lane) * 16) = pack8(VV[tt], s);
        }
    }
    __syncthreads();
}
template <int I> struct SolveRow {
    template <class X> static DI void run(const LAS float* As, X& x, const float (&rhs)[64]) {
        SolveRow<I - 1>::run(As, x, rhs);
        float a4[4] = {rhs[I], 0.f, 0.f, 0.f};
#pragma unroll
        for (int j4 = 0; j4 < (I + 3) / 4; ++j4) { const f32x4 c = *(const LAS f32x4*)(As + I * 68 + 4 * j4);
#pragma unroll
            for (int e = 0; e < 4; ++e) if (4 * j4 + e < I) a4[e] = __builtin_fmaf(c[e], -x[4 * j4 + e], a4[e]); }
        x[I] = (a4[0] + a4[1]) + (a4[2] + a4[3]);
    }
};
template <> struct SolveRow<-1> { template <class X> static DI void run(const LAS float*, X&, const float (&)[64]) {} };

#ifndef PROBE_GDN
#define PROBE_GDN 0
#endif
DI int probe_reps(int which) { int r_ = (PROBE_GDN == which) ? 3 : 1; if (PROBE_GDN) asm volatile("" : "+s"(r_)); return r_; }
DI void gdn_prep_item(Frame& F, const Params& p, int layer, int rec) {
    const int b = rec >> 9, hd = (rec >> 7) & 3, n = rec & 127, t0 = b * SEQ + 64 * n, bstart = b * SEQ, tid = F.tid, lane = F.lane;
    LAS unsigned char* L = F.lds; asm volatile("" : "+s"(L));
    LAS float* qs = (LAS float*)L; LAS float* ks = qs + 64 * 65; LAS float* vs = ks + 64 * 65;
    LAS float* As = (LAS float*)(L + 49920);
    LAS float* gcs = (LAS float*)(L + 67328); LAS float* bts = gcs + 64; LAS float* egc = bts + 64;
    LAS float* Xs = (LAS float*)(L + 68096);
    LAS float* Ts = (LAS float*)(L + 101120);
    const float* Pf = (const float*)(F.ws + WS_PF);
#pragma unroll
    for (int k = 0; k < 3; ++k) {
        const int part = k, rem = tid, t = rem >> 3, seg = rem & 7, ch = part * 256 + 64 * hd + 8 * seg;
        const bf16_t* pl = plane(F, PL_GQ + part) + 64 * hd + 8 * seg; const f32x4* w = (const f32x4*)(p.in[18] + ((size_t)layer * 768 + ch) * 4);
        float acc[8];
#pragma unroll
        for (int e = 0; e < 8; ++e) acc[e] = 0.f;
        f32x4 wv[8];
#pragma unroll
        for (int e = 0; e < 8; ++e) wv[e] = w[e];
#pragma unroll
        for (int j = 0; j < 4; ++j) { const int tt = t0 + t - 3 + j; const int tc = tt >= bstart ? tt : bstart; const float keep = tt >= bstart ? 1.f : 0.f;
            const u32x4 raw = *(const u32x4*)(pl + (size_t)tc * 256);
#pragma unroll
            for (int e = 0; e < 4; ++e) { acc[2 * e] = __builtin_fmaf(wv[2 * e][j] * keep, bflo(raw[e]), acc[2 * e]); acc[2 * e + 1] = __builtin_fmaf(wv[2 * e + 1][j] * keep, bfhi(raw[e]), acc[2 * e + 1]); } }
#pragma unroll
        for (int e = 0; e < 8; ++e) qs[part * 4160 + t * 65 + 8 * seg + e] = silu_f(acc[e]);
    }
    __syncthreads();
    {
        const int t = tid >> 3, seg = tid & 7; float sq = 0.f, sk = 0.f;
        float qa[8], ka[8];
#pragma unroll
        for (int e = 0; e < 8; ++e) { qa[e] = qs[t * 65 + seg * 8 + e]; ka[e] = ks[t * 65 + seg * 8 + e]; }
        __builtin_amdgcn_sched_barrier(0);
#pragma unroll
        for (int e = 0; e < 8; ++e) { sq += qa[e] * qa[e]; sk += ka[e] * ka[e]; }
        sq += shx<1>(sq); sq += shx<2>(sq); sq += shx<4>(sq);
        sk += shx<1>(sk); sk += shx<2>(sk); sk += shx<4>(sk);
        const float rq = rsqrtf(sq + EPS) * 0.125f, rk = rsqrtf(sk + EPS);
#pragma unroll
        for (int e = 0; e < 8; ++e) { qs[t * 65 + seg * 8 + e] = qa[e] * rq; ks[t * 65 + seg * 8 + e] = ka[e] * rk; }
        if (tid < 64) {
            const float a = Pf[(size_t)(t0 + tid) * 256 + PF_GA + hd], bb = Pf[(size_t)(t0 + tid) * 256 + PF_GB + hd];
            const float xx = a + p.in[20][layer * 4 + hd]; const float ee = expf(-fabsf(xx)); const float l1p = (ee < 1e-2f) ? ee * (1.f - ee * (0.5f - ee * 0.33333333f)) : logf(1.f + ee); const float sp = fmaxf(xx, 0.f) + l1p;
            const float g = -expf(p.in[19][layer * 4 + hd]) * sp;
            bts[tid] = 1.f / (1.f + expf(-bb));
            gcs[tid] = g;
        }
    }
    __syncthreads();
    float run_ = 0.f;
    if (tid < 64) {
#pragma unroll
        for (int b4 = 0; b4 < 4; ++b4) {
            const LAS f32x4* gp = (const LAS f32x4*)(gcs + 16 * b4); const f32x4 g0 = gp[0], g1 = gp[1], g2 = gp[2], g3 = gp[3];
            __builtin_amdgcn_sched_barrier(0);
#pragma unroll
            for (int i = 0; i < 16; ++i) { const float gi = (i >> 2) == 0 ? g0[i & 3] : (i >> 2) == 1 ? g1[i & 3] : (i >> 2) == 2 ? g2[i & 3] : g3[i & 3]; run_ += (16 * b4 + i <= tid) ? gi : 0.f; }
            __builtin_amdgcn_sched_barrier(0);
        }
    }
    __syncthreads();
    if (tid < 64) { gcs[tid] = run_; egc[tid] = expf(run_); }
    __syncthreads();
    {
        const int wv_ = F.wave, m = wv_ >> 2, ti = (wv_ >> 1) & 1, tj = wv_ & 1, r = lane & 31, h = lane >> 5;
        f32x16 acc;
#pragma unroll
        for (int i = 0; i < 16; ++i) acc[i] = 0.f;
        if (ti >= tj) {
            const LAS float* ap = (m ? qs : ks) + (32 * ti + r) * 65 + h; const LAS float* bp = ks + (32 * tj + r) * 65 + h;
            {
                float av_[2][8], bv_[2][8];
#pragma unroll
                for (int k = 0; k < 8; ++k) { av_[0][k] = ap[2 * k]; bv_[0][k] = bp[2 * k]; }
#pragma unroll
                for (int s8 = 0; s8 < 4; ++s8) {
                    if (s8 + 1 < 4) {
#pragma unroll
                        for (int k = 0; k < 8; ++k) { av_[(s8 + 1) & 1][k] = ap[2 * (8 * (s8 + 1) + k)]; bv_[(s8 + 1) & 1][k] = bp[2 * (8 * (s8 + 1) + k)]; }
                    }
                    __builtin_amdgcn_sched_barrier(0);
#pragma unroll
                    for (int k = 0; k < 8; ++k) acc = __builtin_amdgcn_mfma_f32_32x32x2f32(av_[s8 & 1][k], bv_[s8 & 1][k], acc, 0, 0, 0);
                    __builtin_amdgcn_sched_barrier(0);
                }
            }
        }
        const int j = 32 * tj + r; const float gj = gcs[j];
        float gi_[16], bi_[16];
#pragma unroll
        for (int i2 = 0; i2 < 16; ++i2) { const int i = 32 * ti + crow(i2, h); gi_[i2] = gcs[i]; bi_[i2] = bts[i]; }
        __builtin_amdgcn_sched_barrier(0);
#pragma unroll
        for (int i2 = 0; i2 < 16; ++i2) { const int i = 32 * ti + crow(i2, h); const float dec = (i >= j) ? __expf(gi_[i2] - gj) : 0.f;
            if (m == 0) As[i * 68 + j] = (i > j) ? bi_[i2] * acc[i2] * dec : 0.f; else Ts[i * 65 + j] = acc[i2] * dec; }
    }
    __syncthreads();
    {
        float xv[16];
#pragma unroll
        for (int k = 0; k < 16; ++k) { const int i = tid + 512 * k, row = i >> 7, c = i & 127;
            xv[k] = (c < 64) ? vs[row * 65 + c] * bts[row] : ks[row * 65 + (c - 64)] * bts[row] * egc[row]; }
        __builtin_amdgcn_sched_barrier(0);
#pragma unroll
        for (int k = 0; k < 16; ++k) { const int i = tid + 512 * k, row = i >> 7, c = i & 127; Xs[row * 129 + c] = xv[k]; }
    }
    __syncthreads();
    {
        const int wv_ = F.wave, c0 = 16 * wv_, n = lane & 15, qd = lane >> 4;
        typedef float f32x4v __attribute__((ext_vector_type(4)));
#pragma unroll
        for (int bb = 0; bb < 4; ++bb) {
            if (bb > 0) {
                f32x4v acc;
#pragma unroll
                for (int e = 0; e < 4; ++e) acc[e] = Xs[(16 * bb + 4 * qd + e) * 129 + c0 + n];
                float av_[12], bv_[12];
#pragma unroll
                for (int cb = 0; cb < bb; ++cb)
#pragma unroll
                    for (int s4 = 0; s4 < 4; ++s4) {
                        av_[4 * cb + s4] = As[(16 * bb + n) * 68 + 16 * cb + 4 * s4 + qd];
                        bv_[4 * cb + s4] = Xs[(16 * cb + 4 * s4 + qd) * 129 + c0 + n];
                    }
                __builtin_amdgcn_sched_barrier(0);
#pragma unroll
                for (int cb = 0; cb < bb; ++cb)
#pragma unroll
                    for (int s4 = 0; s4 < 4; ++s4) acc = __builtin_amdgcn_mfma_f32_16x16x4f32(-av_[4 * cb + s4], bv_[4 * cb + s4], acc, 0, 0, 0);
#pragma unroll
                for (int e = 0; e < 4; ++e) Xs[(16 * bb + 4 * qd + e) * 129 + c0 + n] = acc[e];
            }
            if (lane < 16) {
                float x[16], r0[16];
#pragma unroll
                for (int i = 0; i < 16; ++i) r0[i] = Xs[(16 * bb + i) * 129 + c0 + lane];
#pragma unroll
                for (int i4 = 0; i4 < 4; ++i4) {
                    f32x4 cc[4][4];
#pragma unroll
                    for (int ii = 0; ii < 4; ++ii)
#pragma unroll
                        for (int j4 = 0; j4 <= i4; ++j4) cc[ii][j4] = *(const LAS f32x4*)(As + (16 * bb + 4 * i4 + ii) * 68 + 16 * bb + 4 * j4);
                    __builtin_amdgcn_sched_barrier(0);
#pragma unroll
                    for (int ii = 0; ii < 4; ++ii) { const int i = 4 * i4 + ii;
                        float a4[4] = {r0[i], 0.f, 0.f, 0.f};
#pragma unroll
                        for (int j4 = 0; j4 <= i4; ++j4)
#pragma unroll
                            for (int e = 0; e < 4; ++e) if (4 * j4 + e < i) a4[e] = __builtin_fmaf(cc[ii][j4][e], -x[4 * j4 + e], a4[e]);
                        x[i] = (a4[0] + a4[1]) + (a4[2] + a4[3]);
                    }
                }
#pragma unroll
                for (int i = 0; i < 16; ++i) Xs[(16 * bb + i) * 129 + c0 + lane] = x[i];
            }
        }
    }
    __syncthreads();
    {
        unsigned char* recp = (unsigned char*)p.out + (size_t)rec * GR_BYTES;
        const int f = tid >> 6, rt = f >> 2, s4 = f & 3, r = lane & 31, h = lane >> 5, row = 32 * rt + r;
        const float gl = gcs[63];
        float vw[8], vq[8], va[8], vk[8];
#pragma unroll
        for (int j = 0; j < 8; ++j) { const int kidx = 16 * s4 + 8 * (j >> 2) + 4 * h + (j & 3);
            vw[j] = Xs[row * 129 + 64 + kidx]; vq[j] = qs[row * 65 + kidx] * egc[row]; va[j] = Ts[row * 65 + kidx]; vk[j] = ks[kidx * 65 + row] * __expf(gl - gcs[kidx]); }
        u32x4 w;
        w.x = pk2(vw[0], vw[1]); w.y = pk2(vw[2], vw[3]); w.z = pk2(vw[4], vw[5]); w.w = pk2(vw[6], vw[7]); *(u32x4*)(recp + GR_W + (f * 64 + lane) * 16) = w;
        w.x = pk2(vq[0], vq[1]); w.y = pk2(vq[2], vq[3]); w.z = pk2(vq[4], vq[5]); w.w = pk2(vq[6], vq[7]); *(u32x4*)(recp + GR_QG + (f * 64 + lane) * 16) = w;
        w.x = pk2(va[0], va[1]); w.y = pk2(va[2], va[3]); w.z = pk2(va[4], va[5]); w.w = pk2(va[6], va[7]); *(u32x4*)(recp + GR_ATT + (f * 64 + lane) * 16) = w;
        w.x = pk2(vk[0], vk[1]); w.y = pk2(vk[2], vk[3]); w.z = pk2(vk[4], vk[5]); w.w = pk2(vk[6], vk[7]); *(u32x4*)(recp + GR_KGT + (f * 64 + lane) * 16) = w;
        const int vt = f >> 2, ct = (f >> 1) & 1, i0 = 8 * (f & 1);
        f32x4 u0, u1;
#pragma unroll
        for (int e = 0; e < 4; ++e) { u0[e] = Xs[(32 * ct + crow(i0 + e, h)) * 129 + 32 * vt + r]; u1[e] = Xs[(32 * ct + crow(i0 + 4 + e, h)) * 129 + 32 * vt + r]; }
        float* up = (float*)(recp + GR_U) + ((vt * 2 + ct) * 64 + lane) * 16 + i0;
        *(f32x4*)up = u0; *(f32x4*)(up + 4) = u1;
        if (tid == 0) ((float*)(F.ws + WS_EG))[rec] = expf(gl);
    }
    __syncthreads();
}
#ifndef PROBE_PREP
#define PROBE_PREP 0
#endif
DI void phase_prep(Frame& F, const Params& p, int layer) {
    for (int it = F.bid; it < 2048; it += F.G) {
        int reps = 1;
        if (PROBE_PREP) { const int ty = it < 1024 ? 1 : it < 1536 ? 2 : it < 1792 ? 3 : 4; reps = (ty == PROBE_PREP) ? 3 : 1; asm volatile("" : "+s"(reps)); }
#pragma unroll 1
        for (int rp = 0; rp < reps; ++rp) {
            int it2 = it; if (PROBE_PREP) asm volatile("" : "+s"(it2));
            if (it2 < 1024) gdn_prep_item(F, p, layer, it2);
            else if (it2 < 1536) sg_item(F, p, layer, (it2 - 1024) >> 2, (it2 - 1024) & 3);
            else if (it2 < 1792) dsa_prep_item(F, p, layer, it2 - 1536);
            else sc_item(F, p, layer, it2 - 1792);
        }
    }
}

DI void gdn_scan(Frame& F, const Params& p, int layer, int bh) {
    const int b = bh >> 2, hd = bh & 3, tid = F.tid, lane = F.lane, wave = F.wave, r = lane & 31, h = lane >> 5;
    const unsigned char* rec0 = (unsigned char*)p.out + (size_t)(bh * 128) * GR_BYTES;
    const float* EG = (const float*)(F.ws + WS_EG) + bh * 128;
    float* obuf = (float*)(F.ws + WS_OBUF);
    LAS unsigned char* lds = F.lds;
    LAS float* egs = (LAS float*)(lds + 2 * GR_BYTES);
    for (int i = tid; i < GR_BYTES / 16; i += 512) *(LAS u32x4*)(lds + i * 16) = *(const u32x4*)(rec0 + i * 16);
    if (tid == 0) egs[0] = EG[0];
    __syncthreads();
    f32x16 S0, S1;
#pragma unroll
    for (int i = 0; i < 16; ++i) { S0[i] = 0.f; S1[i] = 0.f; }
    u32x4 pv[8]; float pe = 0.f;
    if (wave >= 2) {
        const unsigned char* src = rec0 + (size_t)1 * GR_BYTES;
#pragma unroll
        for (int k = 0; k < 8; ++k) pv[k] = *(const u32x4*)(src + ((tid - 128) + 384 * k) * 16);
        if (tid == 128) pe = EG[1];
    }
    for (int n = 0; n < 128; ++n) {
        LAS unsigned char* st = lds + (n & 1) * GR_BYTES;
        if (wave >= 2) {
            if (n + 1 < 128) {
                LAS unsigned char* dst = lds + ((n + 1) & 1) * GR_BYTES;
#pragma unroll
                for (int k = 0; k < 8; ++k) *(LAS u32x4*)(dst + ((tid - 128) + 384 * k) * 16) = pv[k];
                if (tid == 128) egs[(n + 1) & 1] = pe;
            }
            if (n + 2 < 128) {
                const unsigned char* src = rec0 + (size_t)(n + 2) * GR_BYTES;
#pragma unroll
                for (int k = 0; k < 8; ++k) pv[k] = *(const u32x4*)(src + ((tid - 128) + 384 * k) * 16);
                if (tid == 128) pe = EG[n + 2];
            }
        } else {
            const int vt = wave;
            const float eg = egs[n & 1];
#define GFRAG(off, f) (*(const LAS bf16x8*)(st + (off) + ((f) * 64 + lane) * 16))
            const bf16x8 sb0 = pack8(S0, 0), sb1 = pack8(S0, 1), sb2 = pack8(S1, 0), sb3 = pack8(S1, 1);
            f32x16 ws0, ws1, o0, o1;
#pragma unroll
            for (int i = 0; i < 16; ++i) { ws0[i] = 0.f; ws1[i] = 0.f; o0[i] = 0.f; o1[i] = 0.f; }
            ws0 = MFMA32(GFRAG(GR_W, 0), sb0, ws0); ws0 = MFMA32(GFRAG(GR_W, 1), sb1, ws0); ws0 = MFMA32(GFRAG(GR_W, 2), sb2, ws0); ws0 = MFMA32(GFRAG(GR_W, 3), sb3, ws0);
            ws1 = MFMA32(GFRAG(GR_W, 4), sb0, ws1); ws1 = MFMA32(GFRAG(GR_W, 5), sb1, ws1); ws1 = MFMA32(GFRAG(GR_W, 6), sb2, ws1); ws1 = MFMA32(GFRAG(GR_W, 7), sb3, ws1);
            o0 = MFMA32(GFRAG(GR_QG, 0), sb0, o0); o0 = MFMA32(GFRAG(GR_QG, 1), sb1, o0); o0 = MFMA32(GFRAG(GR_QG, 2), sb2, o0); o0 = MFMA32(GFRAG(GR_QG, 3), sb3, o0);
            o1 = MFMA32(GFRAG(GR_QG, 4), sb0, o1); o1 = MFMA32(GFRAG(GR_QG, 5), sb1, o1); o1 = MFMA32(GFRAG(GR_QG, 6), sb2, o1); o1 = MFMA32(GFRAG(GR_QG, 7), sb3, o1);
            const f32x16 u0 = *(const LAS f32x16*)(st + GR_U + ((vt * 2 + 0) * 64 + lane) * 64), u1 = *(const LAS f32x16*)(st + GR_U + ((vt * 2 + 1) * 64 + lane) * 64);
            const f32x16 vn0 = u0 - ws0, vn1 = u1 - ws1;
            const bf16x8 vb0 = pack8(vn0, 0), vb1 = pack8(vn0, 1), vb2 = pack8(vn1, 0), vb3 = pack8(vn1, 1);
            o0 = MFMA32(GFRAG(GR_ATT, 0), vb0, o0); o0 = MFMA32(GFRAG(GR_ATT, 1), vb1, o0); o0 = MFMA32(GFRAG(GR_ATT, 2), vb2, o0); o0 = MFMA32(GFRAG(GR_ATT, 3), vb3, o0);
            o1 = MFMA32(GFRAG(GR_ATT, 4), vb0, o1); o1 = MFMA32(GFRAG(GR_ATT, 5), vb1, o1); o1 = MFMA32(GFRAG(GR_ATT, 6), vb2, o1); o1 = MFMA32(GFRAG(GR_ATT, 7), vb3, o1);
            S0 = S0 * eg; S1 = S1 * eg;
            S0 = MFMA32(GFRAG(GR_KGT, 0), vb0, S0); S0 = MFMA32(GFRAG(GR_KGT, 1), vb1, S0); S0 = MFMA32(GFRAG(GR_KGT, 2), vb2, S0); S0 = MFMA32(GFRAG(GR_KGT, 3), vb3, S0);
            S1 = MFMA32(GFRAG(GR_KGT, 4), vb0, S1); S1 = MFMA32(GFRAG(GR_KGT, 5), vb1, S1); S1 = MFMA32(GFRAG(GR_KGT, 6), vb2, S1); S1 = MFMA32(GFRAG(GR_KGT, 7), vb3, S1);
#undef GFRAG
            float* ob = obuf + (size_t)(b * SEQ + 64 * n) * 256 + 64 * hd + 32 * vt + r;
#pragma unroll
            for (int i = 0; i < 16; ++i) { ob[(size_t)crow(i, h) * 256] = o0[i]; ob[(size_t)(32 + crow(i, h)) * 256] = o1[i]; }
        }
        __syncthreads();
    }
    __syncthreads();
}
DI void gdn_finalize_bh(Frame& F, const Params& p, int layer, int bh);
DI void gdn_finalize(Frame& F, const Params& p, int layer) {
    const float* obuf = (const float*)(F.ws + WS_OBUF); const bf16_t* Pg = plane(F, PL_GG); bf16_t* Y = (bf16_t*)(F.ws + WS_Y);
    const float* gnp = p.in[21] + layer * 64;
    for (int i = F.bid * 512 + F.tid; i < MTOK * 16; i += F.G * 512) {
        const int tok = i >> 4, hd = (i >> 2) & 3, qd = i & 3;
        const f32x4* src = (const f32x4*)(obuf + (size_t)tok * 256 + 64 * hd + 16 * qd);
        f32x4 o[4]; float ss = 0.f;
#pragma unroll
        for (int k = 0; k < 4; ++k) { o[k] = src[k]; ss += (o[k][0] * o[k][0] + o[k][1] * o[k][1]) + (o[k][2] * o[k][2] + o[k][3] * o[k][3]); }
        ss += shx<1>(ss); ss += shx<2>(ss);
        const float rr = rsqrtf(ss * (1.f / 64.f) + EPS);
        const u32x4* gsrc = (const u32x4*)(Pg + (size_t)tok * 256 + 64 * hd + 16 * qd);
        const u32x4 g0 = gsrc[0], g1 = gsrc[1];
        float gt[16];
#pragma unroll
        for (int e = 0; e < 4; ++e) { gt[2 * e] = bflo(g0[e]); gt[2 * e + 1] = bfhi(g0[e]); gt[8 + 2 * e] = bflo(g1[e]); gt[8 + 2 * e + 1] = bfhi(g1[e]); }
        float y[16];
#pragma unroll
        for (int k = 0; k < 4; ++k) { const f32x4 gn = *(const f32x4*)(gnp + 16 * qd + 4 * k);
#pragma unroll
            for (int e = 0; e < 4; ++e) y[4 * k + e] = o[k][e] * rr * gn[e] * silu_f(gt[4 * k + e]); }
        u32x4 w0, w1;
        w0.x = pk2(y[0], y[1]); w0.y = pk2(y[2], y[3]); w0.z = pk2(y[4], y[5]); w0.w = pk2(y[6], y[7]);
        w1.x = pk2(y[8], y[9]); w1.y = pk2(y[10], y[11]); w1.z = pk2(y[12], y[13]); w1.w = pk2(y[14], y[15]);
        u32x4* dst = (u32x4*)(Y + (size_t)tok * 1024 + 768 + 64 * hd + 16 * qd);
        dst[0] = w0; dst[1] = w1;
    }
}

DI void gdn_finalize_bh(Frame& F, const Params& p, int layer, int bh) {
    const int b = bh >> 2, hd = bh & 3;
    const float* obuf = (const float*)(F.ws + WS_OBUF); const bf16_t* Pg = plane(F, PL_GG); bf16_t* Y = (bf16_t*)(F.ws + WS_Y);
    const float* gnp = p.in[21] + layer * 64;
    for (int i0 = F.tid; i0 < SEQ * 4; i0 += 4 * 512) {
        f32x4 o[4][4]; u32x4 g0[4], g1[4];
#pragma unroll
        for (int k4 = 0; k4 < 4; ++k4) { const int i = i0 + 512 * k4, tok = b * SEQ + (i >> 2), qd = i & 3;
            const f32x4* src = (const f32x4*)(obuf + (size_t)tok * 256 + 64 * hd + 16 * qd);
#pragma unroll
            for (int k = 0; k < 4; ++k) o[k4][k] = src[k];
            const u32x4* gsrc = (const u32x4*)(Pg + (size_t)tok * 256 + 64 * hd + 16 * qd); g0[k4] = gsrc[0]; g1[k4] = gsrc[1]; }
        asm volatile("" ::: "memory");
#pragma unroll
        for (int k4 = 0; k4 < 4; ++k4) { const int i = i0 + 512 * k4, tok = b * SEQ + (i >> 2), qd = i & 3;
            float ss = 0.f;
#pragma unroll
            for (int k = 0; k < 4; ++k) ss += (o[k4][k][0] * o[k4][k][0] + o[k4][k][1] * o[k4][k][1]) + (o[k4][k][2] * o[k4][k][2] + o[k4][k][3] * o[k4][k][3]);
            ss += shx<1>(ss); ss += shx<2>(ss);
            const float rr = rsqrtf(ss * (1.f / 64.f) + EPS);
            float gt[16];
#pragma unroll
            for (int e = 0; e < 4; ++e) { gt[2 * e] = bflo(g0[k4][e]); gt[2 * e + 1] = bfhi(g0[k4][e]); gt[8 + 2 * e] = bflo(g1[k4][e]); gt[8 + 2 * e + 1] = bfhi(g1[k4][e]); }
            float y[16];
#pragma unroll
            for (int k = 0; k < 4; ++k) { const f32x4 gn = *(const f32x4*)(gnp + 16 * qd + 4 * k);
#pragma unroll
                for (int e = 0; e < 4; ++e) y[4 * k + e] = o[k4][k][e] * rr * gn[e] * silu_f(gt[4 * k + e]); }
            u32x4 w0, w1;
            w0.x = pk2(y[0], y[1]); w0.y = pk2(y[2], y[3]); w0.z = pk2(y[4], y[5]); w0.w = pk2(y[6], y[7]);
            w1.x = pk2(y[8], y[9]); w1.y = pk2(y[10], y[11]); w1.z = pk2(y[12], y[13]); w1.w = pk2(y[14], y[15]);
            u32x4* dst = (u32x4*)(Y + (size_t)tok * 1024 + 768 + 64 * hd + 16 * qd);
            dst[0] = w0; dst[1] = w1; }
    }
}

DI unsigned f2key(float s) { const unsigned u = __float_as_uint(s); const int m = (int)u >> 31; return u ^ ((unsigned)m | 0x80000000u); }
DI float relu_f(float x) { return __builtin_amdgcn_fmed3f(x, 0.f, 3.0e38f); }
DI float max_f(float a, float b) { return __builtin_amdgcn_fmed3f(a, b, 3.0e38f); }
DI int hidx(int q, int word) { return word * 32 + q; }
constexpr int DSA_IQF = 131072;
constexpr int DSA_MISC = 147456;

DI bf16x8 ld16(const void* base, unsigned byteoff) { return *(const bf16x8*)((const unsigned char*)base + byteoff); }
DI void dsa_load_ik(const unsigned char* recs, int tile, int lane, bf16x8 (&a)[4]) {
    const unsigned off = (unsigned)tile * (unsigned)TILE_BYTES + TR_IK + 16u * lane;
#pragma unroll
    for (int ks = 0; ks < 4; ++ks) a[ks] = ld16(recs, off + 1024u * ks);
}
DI void dsa_tile_scores(const bf16x8 (&a)[4], const bf16x8 (&Biq)[4][4], const float (&w)[4], f32x16& sc) {
#pragma unroll
    for (int hd = 0; hd < 4; ++hd) {
        f32x16 S;
#pragma unroll
        for (int i = 0; i < 16; ++i) S[i] = 0.f;
#pragma unroll
        for (int ks = 0; ks < 4; ++ks) S = MFMA32(a[ks], Biq[hd][ks], S);
#pragma unroll
        for (int i = 0; i < 16; ++i) { const float rl = relu_f(S[i]); sc[i] = __builtin_fmaf(w[hd], rl, (hd == 0) ? 0.0f : sc[i]); }
    }
}
DI bf16x8 load_q_frag(const bf16_t* pl, const float* rope, int row, int hd, int ks, int h, float scale) {
    const u32x4 raw = *(const u32x4*)(pl + (size_t)row * 256 + 64 * hd + 16 * ks + 8 * h);
    float x[8];
#pragma unroll
    for (int e = 0; e < 4; ++e) { x[2 * e] = bflo(raw[e]); x[2 * e + 1] = bfhi(raw[e]); }
    if (ks == 0) {
        const u32x4 oth = *(const u32x4*)(pl + (size_t)row * 256 + 64 * hd + 8 * (1 - h));
        const float* rp = rope + (size_t)row * 16;
#pragma unroll
        for (int e = 0; e < 4; ++e) {
            const float o0 = bflo(oth[e]), o1 = bfhi(oth[e]);
            const float c0 = rp[2 * e], s0 = rp[8 + 2 * e], c1 = rp[2 * e + 1], s1 = rp[8 + 2 * e + 1];
            x[2 * e] = h ? (x[2 * e] * c0 + o0 * s0) : (x[2 * e] * c0 - o0 * s0);
            x[2 * e + 1] = h ? (x[2 * e + 1] * c1 + o1 * s1) : (x[2 * e + 1] * c1 - o1 * s1);
        }
    }
    u32x4 w; w.x = pk2(x[0] * scale, x[1] * scale); w.y = pk2(x[2] * scale, x[3] * scale); w.z = pk2(x[4] * scale, x[5] * scale); w.w = pk2(x[6] * scale, x[7] * scale);
    return __builtin_bit_cast(bf16x8, w);
}
DI bf16x8 load_qp_frag(const bf16_t* pl, const float* rope, int row, int hd, int ks, int h, float scale) {
    const u32x2 lo = *(const u32x2*)(pl + (size_t)row * 256 + 64 * hd + 16 * ks + 4 * h), hi = *(const u32x2*)(pl + (size_t)row * 256 + 64 * hd + 16 * ks + 8 + 4 * h);
    float x[8];
    x[0] = bflo(lo.x); x[1] = bfhi(lo.x); x[2] = bflo(lo.y); x[3] = bfhi(lo.y); x[4] = bflo(hi.x); x[5] = bfhi(hi.x); x[6] = bflo(hi.y); x[7] = bfhi(hi.y);
    if (ks == 0) {
        const float* rp = rope + (size_t)row * 16 + 4 * h;
#pragma unroll
        for (int j = 0; j < 4; ++j) { const float cv = rp[j], sv = rp[8 + j], x1 = x[j], x2 = x[j + 4]; x[j] = x1 * cv - x2 * sv; x[j + 4] = x2 * cv + x1 * sv; }
    }
    u32x4 w; w.x = pk2(x[0] * scale, x[1] * scale); w.y = pk2(x[2] * scale, x[3] * scale); w.z = pk2(x[4] * scale, x[5] * scale); w.w = pk2(x[6] * scale, x[7] * scale);
    return __builtin_bit_cast(bf16x8, w);
}
DI void dsa_hist_scan(Frame& F, LAS unsigned* hist, LAS int* need, LAS int* selb, LAS int* ceq, LAS const int* active) {
    const int q = F.tid & 31, sub = F.tid >> 5;
    LAS int* cnts = (LAS int*)(F.lds + DSA_MISC + 3072);
    LAS int* tsub = cnts + 512; LAS int* tabove = tsub + 32;
    {
        int cnt = 0;
#pragma unroll
        for (int b4 = 0; b4 < 4; ++b4) {
            unsigned v[16];
#pragma unroll
            for (int w = 0; w < 16; ++w) v[w] = hist[hidx(q, sub * 64 + b4 * 16 + w)];
            __builtin_amdgcn_sched_barrier(0);
#pragma unroll
            for (int w = 0; w < 16; ++w) cnt += (int)(v[w] & 0xffffu) + (int)(v[w] >> 16);
            __builtin_amdgcn_sched_barrier(0);
        }
        cnts[q * 16 + sub] = cnt;
        __syncthreads();
        int above = 0;
        {
            const LAS u32x4* cp = (const LAS u32x4*)(cnts + q * 16); const u32x4 c0 = cp[0], c1 = cp[1], c2 = cp[2], c3 = cp[3];
            __builtin_amdgcn_sched_barrier(0);
#pragma unroll
            for (int k = 0; k < 16; ++k) { const unsigned c = (k >> 2) == 0 ? c0[k & 3] : (k >> 2) == 1 ? c1[k & 3] : (k >> 2) == 2 ? c2[k & 3] : c3[k & 3]; above += (k > sub) ? (int)c : 0; }
        }
        const int nd = need[q];
        if (above < nd && nd <= above + cnt) { tsub[q] = sub; tabove[q] = above; }
        __syncthreads();
    }
    const int ts = tsub[q], ta = tabove[q], nd = need[q];
    const int w0_ = ts * 64 + sub * 4;
    const unsigned v0 = hist[hidx(q, w0_)], v1 = hist[hidx(q, w0_ + 1)], v2 = hist[hidx(q, w0_ + 2)], v3 = hist[hidx(q, w0_ + 3)];
    __builtin_amdgcn_sched_barrier(0);
    const int c8 = (int)(v0 & 0xffffu) + (int)(v0 >> 16) + (int)(v1 & 0xffffu) + (int)(v1 >> 16) + (int)(v2 & 0xffffu) + (int)(v2 >> 16) + (int)(v3 & 0xffffu) + (int)(v3 >> 16);
    cnts[q * 16 + sub] = c8;
    __syncthreads();
    int above = ta;
    {
        const LAS u32x4* cp = (const LAS u32x4*)(cnts + q * 16); const u32x4 c0 = cp[0], c1 = cp[1], c2 = cp[2], c3 = cp[3];
        __builtin_amdgcn_sched_barrier(0);
#pragma unroll
        for (int k = 0; k < 16; ++k) { const unsigned c = (k >> 2) == 0 ? c0[k & 3] : (k >> 2) == 1 ? c1[k & 3] : (k >> 2) == 2 ? c2[k & 3] : c3[k & 3]; above += (k > sub) ? (int)c : 0; }
    }
    __syncthreads();
    if (active[q] && above < nd && nd <= above + c8) {
        int cum = above; bool done = false;
#pragma unroll
        for (int bk = 7; bk >= 0; --bk) {
            const unsigned v = (bk >> 1) == 3 ? v3 : (bk >> 1) == 2 ? v2 : (bk >> 1) == 1 ? v1 : v0; const int c = (bk & 1) ? (int)(v >> 16) : (int)(v & 0xffffu);
            if (!done && cum + c >= nd) { selb[q] = ts * 128 + sub * 8 + bk; need[q] = nd - cum; ceq[q] = c; done = true; }
            if (!done) cum += c;
        }
    }
    __syncthreads();
}

DI void dsa_item(Frame& Fin, const Params& p, int item) {
    const int b = item & 1, qt = 255 - (item >> 1), q0 = b * SEQ + 32 * qt, nkt = qt + 1;
    int tid = Fin.tid; asm volatile("" : "+v"(tid));
    Frame F = Fin; F.tid = tid; F.lane = tid & 63;
    const int lane = tid & 63, wave = F.wave, r = lane & 31, h = lane >> 5;
    LAS unsigned* hist = (LAS unsigned*)F.lds;
    LAS int* need = (LAS int*)(F.lds + DSA_MISC); LAS int* selb = need + 32; LAS int* ceq = selb + 32; LAS int* active = ceq + 32;
    LAS unsigned* thr = (LAS unsigned*)(active + 32); LAS int* cut = (LAS int*)(thr + 32); LAS int* tief = cut + 32; LAS int* anytie = tief + 32;
    const unsigned char* recs = F.ws + WS_KB + (size_t)b * 256 * TILE_BYTES;
    const float* rope = (const float*)(F.ws + WS_ROPE); const float* Pf = (const float*)(F.ws + WS_PF);
    const bf16_t* Piq = plane(F, PL_IQ); const bf16_t* Pq = plane(F, PL_Q);
    float w[4];
#pragma unroll
    for (int hd = 0; hd < 4; ++hd) w[hd] = Pf[(size_t)(q0 + r) * 256 + PF_IW + hd] * 0.5f;
    bf16x8 Biq[4][4];
#pragma unroll
    for (int hd = 0; hd < 4; ++hd)
#pragma unroll
        for (int ks = 0; ks < 4; ++ks) Biq[hd][ks] = load_q_frag(Piq, rope, q0 + r, hd, ks, h, 0.125f);
    const int qpos = 32 * qt + r;
    if (tid < 32) { const int nv = 32 * qt + tid + 1; need[tid] = nv < 256 ? nv : 256; active[tid] = nv > 256; thr[tid] = 0u; cut[tid] = SEQ; tief[tid] = 0; selb[tid] = 0; ceq[tid] = 0; }
    if (tid == 0) anytie[0] = 0;
    unsigned pre = 0u;
#define DSA_HIST_PASS(PASS) do { \
        for (int i_ = tid; i_ < 32 * 1024 / 4; i_ += 512) *(LAS u32x4*)(hist + 4 * i_) = (u32x4){0u, 0u, 0u, 0u}; \
        __syncthreads(); \
        LAS unsigned* hrow = hist + r; \
        bf16x8 an[4]; \
        if (wave < nkt) dsa_load_ik(recs, wave, lane, an); \
        for (int kt = wave; kt < nkt; kt += 8) { \
            bf16x8 a[4]; \
            _Pragma("unroll") for (int ks = 0; ks < 4; ++ks) a[ks] = an[ks]; \
            if (kt + 8 < nkt) dsa_load_ik(recs, kt + 8, lane, an); \
            f32x16 sc; dsa_tile_scores(a, Biq, w, sc); \
            if (kt < qt) {        \
                _Pragma("unroll") for (int i = 0; i < 16; ++i) { \
                    const unsigned key = f2key(sc[i]); \
                    if (PASS == 0) { __hip_atomic_fetch_add(hrow + ((key >> 22) << 5), 1u + 0xffffu * ((key >> 21) & 1u), __ATOMIC_RELAXED, __HIP_MEMORY_SCOPE_WORKGROUP); } \
                    else if (PASS == 1) { const unsigned val = ((key >> 21) == pre) ? (1u + 0xffffu * ((key >> 10) & 1u)) : 0u; __hip_atomic_fetch_add(hrow + (((key >> 11) & 1023u) << 5), val, __ATOMIC_RELAXED, __HIP_MEMORY_SCOPE_WORKGROUP); } \
                    else { const unsigned val = ((key >> 10) == pre) ? (1u + 0xffffu * (key & 1u)) : 0u; __hip_atomic_fetch_add(hrow + (((key >> 1) & 511u) << 5), val, __ATOMIC_RELAXED, __HIP_MEMORY_SCOPE_WORKGROUP); } \
                } \
            } else {              \
                const int limh = qpos - 32 * kt - 4 * h; \
                _Pragma("unroll") for (int i = 0; i < 16; ++i) { \
                    const unsigned key = f2key(sc[i]); \
                    bool ok = ((i & 3) + 8 * (i >> 2)) <= limh; unsigned bk; \
                    if (PASS == 0) bk = key >> 21; else if (PASS == 1) { ok = ok & ((key >> 21) == pre); bk = (key >> 10) & 2047u; } else { ok = ok & ((key >> 10) == pre); bk = key & 1023u; } \
                    const unsigned val = ok ? (1u + 0xffffu * (bk & 1u)) : 0u; \
                    __hip_atomic_fetch_add(hrow + ((bk >> 1) << 5), val, __ATOMIC_RELAXED, __HIP_MEMORY_SCOPE_WORKGROUP); \
                } \
            } \
        } \
        __syncthreads(); \
        dsa_hist_scan(F, hist, need, selb, ceq, active); \
    } while (0)
    LAS unsigned short* Gm = (LAS unsigned short*)F.lds;
    LAS unsigned short* Em = (LAS unsigned short*)(F.lds + 32768);
    LAS unsigned* tiebm = (LAS unsigned*)(F.lds + 65536);
    LAS unsigned* clist = (LAS unsigned*)(F.lds + 98304);
    LAS int* lcnt = anytie + 32; LAS int* lomin = lcnt + 32; LAS int* himax = lomin + 32; LAS int* fback = himax + 32;
    if (tid < 32) { lcnt[tid] = 0; lomin[tid] = 1024; himax[tid] = -1; } if (tid == 0) fback[0] = 0;
    if (qt >= 8) {
        DSA_HIST_PASS(0); pre = (unsigned)selb[r];
        DSA_HIST_PASS(1); pre = (pre << 11) | (unsigned)selb[r];
    }
    if (tid < 32 && active[tid]) { if (ceq[tid] > need[tid]) { tief[tid] = 1; anytie[0] = 1; } }
    __syncthreads();
    const unsigned P22 = active[r] ? pre : 0u;
    if (anytie[0]) { for (int i = tid; i < 32 * 256; i += 512) tiebm[i] = 0u; }
    __syncthreads();
    {
        const bool tf = tief[r] != 0;
        bf16x8 an[4];
        if (wave < nkt) dsa_load_ik(recs, wave, lane, an);
        for (int kt = wave; kt < nkt; kt += 8) {
            bf16x8 a[4];
#pragma unroll
            for (int ks = 0; ks < 4; ++ks) a[ks] = an[ks];
            if (kt + 8 < nkt) dsa_load_ik(recs, kt + 8, lane, an);
            f32x16 sc; dsa_tile_scores(a, Biq, w, sc);
            const int limh = qpos - 32 * kt - 4 * h;
            unsigned g = 0u, e = 0u;
#pragma unroll
            for (int i = 0; i < 16; ++i) { const int ci = (i & 3) + 8 * (i >> 2); const unsigned k22 = f2key(sc[i]) >> 10; const bool valid = ci <= limh;
                g |= (valid & (k22 > P22)) ? (1u << i) : 0u; e |= (valid & (k22 == P22)) ? (1u << i) : 0u; }
            Gm[kt * 64 + lane] = (unsigned short)g; Em[kt * 64 + lane] = (unsigned short)e;
            if (tf && e) {
#pragma unroll
                for (int i = 0; i < 16; ++i) if ((e >> i) & 1u) { const int kidx = 32 * kt + crow(i, h); const int low = (int)(f2key(sc[i]) & 1023u);
                    __hip_atomic_fetch_or(tiebm + hidx(r, kidx >> 5), 1u << (kidx & 31), __ATOMIC_RELAXED, __HIP_MEMORY_SCOPE_WORKGROUP);
                    __hip_atomic_fetch_min(lomin + r, low, __ATOMIC_RELAXED, __HIP_MEMORY_SCOPE_WORKGROUP); __hip_atomic_fetch_max(himax + r, low, __ATOMIC_RELAXED, __HIP_MEMORY_SCOPE_WORKGROUP);
                    const int pos = __hip_atomic_fetch_add(lcnt + r, 1, __ATOMIC_RELAXED, __HIP_MEMORY_SCOPE_WORKGROUP);
                    if (pos < 64) clist[r * 64 + pos] = ((unsigned)low << 13) | (unsigned)kidx; }
            }
        }
    }
    __syncthreads();
    if (anytie[0]) {
        const int q = tid & 31, sub = tid >> 5; const bool fl = tief[q] != 0, pure = fl && lomin[q] == himax[q];
        LAS int* cnts = (LAS int*)(F.lds + DSA_MISC + 3072);
        unsigned wv[16]; int cnt = 0;
#pragma unroll
        for (int k = 0; k < 16; ++k) { wv[k] = tiebm[hidx(q, sub * 16 + k)]; cnt += __popc(wv[k]); }
        cnts[q * 16 + sub] = cnt;
        __syncthreads();
        int before = 0;
        for (int k = 0; k < sub; ++k) before += cnts[q * 16 + k];
        const int nd = need[q];
        if (pure && before < nd && nd <= before + cnt) {
            int rem = nd - before, pos = SEQ; bool done = false;
#pragma unroll
            for (int k = 0; k < 16; ++k) { const int c = __popc(wv[k]);
                if (!done && rem <= c) { unsigned vv = wv[k]; for (int t = 1; t < rem; ++t) vv &= vv - 1; pos = (sub * 16 + k) * 32 + (__ffs(vv) - 1); done = true; }
                if (!done) rem -= c; }
            cut[q] = pos;
        }
        if (fl && !pure) {
            const int n = lcnt[q];
            if (n > 64) { fback[0] = 1; }
            else {
                for (int e0 = sub; e0 < n; e0 += 16) {
                    const unsigned ce = clist[q * 64 + e0]; const unsigned Ke = ((1023u - (ce >> 13)) << 13) | (ce & 8191u);
                    int rank = 0;
                    for (int f = 0; f < n; ++f) { const unsigned cf = clist[q * 64 + f]; const unsigned Kf = ((1023u - (cf >> 13)) << 13) | (cf & 8191u); rank += (Kf < Ke) ? 1 : 0; }
                    if (rank < nd) { const int kidx = (int)(ce & 8191u), kk = kidx & 31, tl = kidx >> 5, hh = (kk >> 2) & 1, ii = (kk & 3) + 4 * (kk >> 3), slot = tl * 64 + hh * 32 + q;
                        __hip_atomic_fetch_or((LAS unsigned*)F.lds + (slot >> 1), (1u << ii) << (16 * (slot & 1)), __ATOMIC_RELAXED, __HIP_MEMORY_SCOPE_WORKGROUP); }
                }
                if (sub == 0) cut[q] = -1;
            }
        }
        __syncthreads();
    }
#ifndef DSA_CHECK
#define DSA_CHECK 0
#endif
    LAS int* badf = fback + 1;
    unsigned short* chk = (unsigned short*)(F.ws + (size_t)244 * MiB) + (size_t)F.bid * 16384;
    if (DSA_CHECK) {
        if (tid == 0) badf[0] = 0;
        for (int slot = tid; slot < 64 * nkt; slot += 512) { const int rr = slot & 31, hh = (slot >> 5) & 1, kt2 = slot >> 6;
            const int cq = tief[rr] ? cut[rr] : SEQ, cuth = cq - 32 * kt2 - 4 * hh; unsigned le = 0u;
            for (int gq = 0; gq < 4; ++gq) { int c = cuth - 8 * gq + 1; c = c < 0 ? 0 : (c > 4 ? 4 : c); le |= ((1u << c) - 1u) << (4 * gq); }
            chk[slot] = (unsigned short)(Gm[slot] | (Em[slot] & le)); }
        __syncthreads();
        if (tid == 0 && qt >= 8) fback[0] = 1;
        __syncthreads();
    }
    if (fback[0]) {
        DSA_HIST_PASS(2); pre = (pre << 10) | (unsigned)selb[r];
        if (tid < 32) { tief[tid] = (active[tid] && ceq[tid] > need[tid]) ? 1 : 0; cut[tid] = SEQ; }
        __syncthreads();
        const unsigned T = active[r] ? pre : 0u;
        for (int i = tid; i < 32 * 256; i += 512) tiebm[i] = 0u;
        __syncthreads();
        {
            const bool tf = tief[r] != 0;
            for (int kt = wave; kt < nkt; kt += 8) {
                bf16x8 a[4]; dsa_load_ik(recs, kt, lane, a);
                f32x16 sc; dsa_tile_scores(a, Biq, w, sc);
                const int limh = qpos - 32 * kt - 4 * h;
                unsigned g = 0u, e = 0u;
#pragma unroll
                for (int i = 0; i < 16; ++i) { const int ci = (i & 3) + 8 * (i >> 2); const unsigned key = f2key(sc[i]); const bool valid = ci <= limh;
                    g |= (valid & (key > T)) ? (1u << i) : 0u; e |= (valid & (key == T)) ? (1u << i) : 0u; }
                Gm[kt * 64 + lane] = (unsigned short)g; Em[kt * 64 + lane] = (unsigned short)e;
                if (tf && e) {
#pragma unroll
                    for (int i = 0; i < 16; ++i) { const int kidx = 32 * kt + crow(i, h);
                        if ((e >> i) & 1u) __hip_atomic_fetch_or(tiebm + hidx(r, kidx >> 5), 1u << (kidx & 31), __ATOMIC_RELAXED, __HIP_MEMORY_SCOPE_WORKGROUP); }
                }
            }
        }
        __syncthreads();
        {
            const int q = tid & 31, sub = tid >> 5;
            LAS int* cnts = (LAS int*)(F.lds + DSA_MISC + 3072);
            unsigned wv[16]; int cnt = 0;
#pragma unroll
            for (int k = 0; k < 16; ++k) { wv[k] = tiebm[hidx(q, sub * 16 + k)]; cnt += __popc(wv[k]); }
            cnts[q * 16 + sub] = cnt;
            __syncthreads();
            int before = 0;
            for (int k = 0; k < sub; ++k) before += cnts[q * 16 + k];
            const int nd = need[q];
            if (tief[q] && before < nd && nd <= before + cnt) {
                int rem = nd - before, pos = SEQ; bool done = false;
#pragma unroll
                for (int k = 0; k < 16; ++k) { const int c = __popc(wv[k]);
                    if (!done && rem <= c) { unsigned vv = wv[k]; for (int t = 1; t < rem; ++t) vv &= vv - 1; pos = (sub * 16 + k) * 32 + (__ffs(vv) - 1); done = true; }
                    if (!done) rem -= c; }
                cut[q] = pos;
            }
            __syncthreads();
        }
    }
#undef DSA_HIST_PASS
    if (DSA_CHECK && qt >= 8) {
        asm volatile("s_waitcnt vmcnt(0)" ::: "memory"); __syncthreads();
        for (int slot = tid; slot < 64 * nkt; slot += 512) { const int rr = slot & 31, hh = (slot >> 5) & 1, kt2 = slot >> 6;
            const int cq = tief[rr] ? cut[rr] : SEQ, cuth = cq - 32 * kt2 - 4 * hh; unsigned le = 0u;
            for (int gq = 0; gq < 4; ++gq) { int c = cuth - 8 * gq + 1; c = c < 0 ? 0 : (c > 4 ? 4 : c); le |= ((1u << c) - 1u) << (4 * gq); }
            const unsigned short eff = (unsigned short)(Gm[slot] | (Em[slot] & le));
            if (eff != __builtin_nontemporal_load(chk + slot)) badf[0] = 1; }
        __syncthreads();
    }
    const int mycut = tief[r] ? cut[r] : SEQ;
    const int hg = wave >> 2, kw = wave & 3;
    f32x16 O[2][2]; float mrun[2], lrun[2];
#pragma unroll
    for (int j = 0; j < 2; ++j) { mrun[j] = -1e30f; lrun[j] = 0.f;
#pragma unroll
        for (int dt = 0; dt < 2; ++dt)
#pragma unroll
            for (int i = 0; i < 16; ++i) O[j][dt][i] = 0.f; }
    bf16x8 Bq[2][4];
#pragma unroll
    for (int j = 0; j < 2; ++j)
#pragma unroll
        for (int ks = 0; ks < 4; ++ks) Bq[j][ks] = load_qp_frag(Pq, rope, q0 + r, 2 * hg + j, ks, h, 0.125f * 1.4426950408889634f);
    bf16x8 kn[2][4];
    if (kw < nkt) {
#pragma unroll
        for (int j = 0; j < 2; ++j)
#pragma unroll
            for (int ks = 0; ks < 4; ++ks) kn[j][ks] = ld16(recs, (unsigned)kw * (unsigned)TILE_BYTES + TR_K + (unsigned)(((2 * hg + j) * 4 + ks) * 64 + lane) * 16u);
    }
    for (int kt = kw; kt < nkt; kt += 4) {
        bf16x8 vf[2][2][2];
#pragma unroll
        for (int j = 0; j < 2; ++j)
#pragma unroll
            for (int dt = 0; dt < 2; ++dt) { const unsigned voff = (unsigned)kt * (unsigned)TILE_BYTES + TR_V + (unsigned)((((2 * hg + j) * 2 + dt) * 2) * 64 + lane) * 16u;
                vf[j][dt][0] = ld16(recs, voff); vf[j][dt][1] = ld16(recs, voff + 1024u); }
        unsigned msk;
        {
            const unsigned g = Gm[kt * 64 + lane], e = Em[kt * 64 + lane];
            const int cuth = mycut - 32 * kt - 4 * h;
            unsigned le = 0u;
#pragma unroll
            for (int gq = 0; gq < 4; ++gq) { int c = cuth - 8 * gq + 1; c = c < 0 ? 0 : (c > 4 ? 4 : c); le |= ((1u << c) - 1u) << (4 * gq); }
            msk = g | (e & le);
        }
        f32x16 S0, S1;
#pragma unroll
        for (int i = 0; i < 16; ++i) { S0[i] = 0.f; S1[i] = 0.f; }
#pragma unroll
        for (int ks = 0; ks < 4; ++ks) { S0 = MFMA32(kn[0][ks], Bq[0][ks], S0); S1 = MFMA32(kn[1][ks], Bq[1][ks], S1); }
        __builtin_amdgcn_sched_barrier(0);
        if (kt + 4 < nkt) {
#pragma unroll
            for (int j = 0; j < 2; ++j)
#pragma unroll
                for (int ks = 0; ks < 4; ++ks) kn[j][ks] = ld16(recs, (unsigned)(kt + 4) * (unsigned)TILE_BYTES + TR_K + (unsigned)(((2 * hg + j) * 4 + ks) * 64 + lane) * 16u);
        }
        __builtin_amdgcn_sched_barrier(0);
#pragma unroll
        for (int j = 0; j < 2; ++j) {
            f32x16& S = j ? S1 : S0;
            float mx = S[0];
#pragma unroll
            for (int i = 1; i < 15; i += 2) asm("v_max3_f32 %0, %1, %2, %3" : "=v"(mx) : "v"(mx), "v"(S[i]), "v"(S[i + 1]));
            mx = max_f(mx, S[15]);
            mx = xmax32(mx);
            const float mnew = (mx > mrun[j] + 8.f) ? mx : mrun[j], alpha = __builtin_amdgcn_exp2f(mrun[j] - mnew);
            float rs;
            {
                const f32x2 mn2 = {mnew, mnew}; f32x2 acc2 = {0.f, 0.f};
#pragma unroll
                for (int i = 0; i < 16; i += 2) {
                    const f32x2 d2 = (f32x2){S[i], S[i + 1]} - mn2;
                    const unsigned e0 = __float_as_uint(__builtin_amdgcn_exp2f(d2.x)) & (unsigned)__builtin_amdgcn_sbfe((int)msk, i, 1);
                    const unsigned e1 = __float_as_uint(__builtin_amdgcn_exp2f(d2.y)) & (unsigned)__builtin_amdgcn_sbfe((int)msk, i + 1, 1);
                    const f32x2 p2 = {__uint_as_float(e0), __uint_as_float(e1)};
                    S[i] = p2.x; S[i + 1] = p2.y; acc2 += p2;
                }
                rs = acc2.x + acc2.y;
            }
            rs = xsum32(rs);
            lrun[j] = lrun[j] * alpha + rs; mrun[j] = mnew;
            const bf16x8 pb0 = pack8(S, 0), pb1 = pack8(S, 1);
            if (__builtin_amdgcn_ballot_w64(alpha != 1.0f) != 0ull) {
#pragma unroll
                for (int dt = 0; dt < 2; ++dt) O[j][dt] = O[j][dt] * alpha;
            }
#pragma unroll
            for (int dt = 0; dt < 2; ++dt) {
                O[j][dt] = MFMA32(vf[j][dt][0], pb0, O[j][dt]);
                O[j][dt] = MFMA32(vf[j][dt][1], pb1, O[j][dt]);
            }
        }
        __builtin_amdgcn_sched_barrier(0);
    }
    __syncthreads();
    LAS float* slots = (LAS float*)F.lds; constexpr int SLOT_F = (64 + 4) * 64;
#pragma unroll
    for (int round = 0; round < 2; ++round) {
        const int half = 2 >> round;
        if (kw >= half && kw < 2 * half) {
            LAS float* s = slots + (hg * 2 + (kw - half)) * SLOT_F + lane;
#pragma unroll
            for (int j = 0; j < 2; ++j) {
#pragma unroll
                for (int dt = 0; dt < 2; ++dt)
#pragma unroll
                    for (int i = 0; i < 16; ++i) s[((j * 2 + dt) * 16 + i) * 64] = O[j][dt][i];
                s[(64 + j) * 64] = mrun[j]; s[(66 + j) * 64] = lrun[j];
            }
        }
        __syncthreads();
        if (kw < half) {
            const LAS float* s = slots + (hg * 2 + kw) * SLOT_F + lane;
#pragma unroll
            for (int j = 0; j < 2; ++j) {
                const float m2 = s[(64 + j) * 64], l2 = s[(66 + j) * 64];
                const float mn = fmaxf(mrun[j], m2), a1 = __builtin_amdgcn_exp2f(mrun[j] - mn), a2 = __builtin_amdgcn_exp2f(m2 - mn);
                lrun[j] = lrun[j] * a1 + l2 * a2; mrun[j] = mn;
#pragma unroll
                for (int dt = 0; dt < 2; ++dt)
#pragma unroll
                    for (int i = 0; i < 16; ++i) O[j][dt][i] = O[j][dt][i] * a1 + s[((j * 2 + dt) * 16 + i) * 64] * a2;
            }
        }
        __syncthreads();
    }
    LAS bf16_t* tile = (LAS bf16_t*)F.lds;
    if (kw == 0) {
#pragma unroll
        for (int j = 0; j < 2; ++j) {
            const int hd = 2 * hg + j; const float inv = 1.f / lrun[j];
#pragma unroll
            for (int dt = 0; dt < 2; ++dt)
#pragma unroll
                for (int g = 0; g < 4; ++g) { u32x2 v; v.x = pk2(O[j][dt][4 * g] * inv, O[j][dt][4 * g + 1] * inv); v.y = pk2(O[j][dt][4 * g + 2] * inv, O[j][dt][4 * g + 3] * inv);
                    *(LAS u32x2*)(tile + r * 264 + 64 * hd + 32 * dt + 8 * g + 4 * h) = v; }
        }
    }
    __syncthreads();
    {
        bf16_t* Y = (bf16_t*)(F.ws + WS_Y);
#pragma unroll
        for (int it = 0; it < 2; ++it) { const int c = it * 512 + tid, row = c >> 5, c16 = c & 31;
            const u32x4 v = *(const LAS u32x4*)(tile + row * 264 + c16 * 8);
            *(u32x4*)(Y + (size_t)(q0 + row) * 1024 + 512 + c16 * 8) = (DSA_CHECK && badf[0]) ? (u32x4){0x7fc07fc0u, 0x7fc07fc0u, 0x7fc07fc0u, 0x7fc07fc0u} : v; }
    }
    __syncthreads();
}
DI void phase_mix(Frame& F, const Params& p, int layer, int qidx) {
#ifndef PROBE_MIX
#define PROBE_MIX 0
#endif
    if (F.bid < 8) { gdn_scan(F, p, layer, F.bid); if (PROBE_MIX == 1 && layer == 0) gdn_scan(F, p, layer, F.bid);
        asm volatile("s_waitcnt vmcnt(0)" ::: "memory"); __syncthreads(); __builtin_amdgcn_fence(__ATOMIC_ACQUIRE, "agent"); asm volatile("s_waitcnt vmcnt(0)" ::: "memory"); __syncthreads();
        gdn_finalize_bh(F, p, layer, F.bid); __syncthreads(); }
    LAS int* itemw = (LAS int*)(F.lds + DSA_MISC + 2048);
    unsigned* const qbase = (unsigned*)(F.ws + WS_CTL) + CW_QCTR + 64 * (2 * layer);
    int qb = F.bid & 1; bool switched = false;
    for (;;) {
        if (F.tid == 0) itemw[0] = (int)atomicAdd(qbase + 64 * qb, 1u);
        __syncthreads();
        const int k = itemw[0];
        __syncthreads();
        if (k >= 256) { if (switched) break; switched = true; qb ^= 1; continue; }
        dsa_item(F, p, qb + 2 * k);
    }
}

constexpr size_t WS_KF = 35 * MiB, WS_VF = 23 * MiB;
DI void xa_relayout(Frame& F) {
    for (int i = F.bid * 512 + F.tid; i < 2 * 2 * 65536; i += F.G * 512) {
        const int isv = i >> 17, l = (i >> 16) & 1, c = i & 65535, lane = c & 63, r = lane & 31, h = lane >> 5, f = (c >> 6) & 127, bh = c >> 13, b = bh >> 2, hd = bh & 3;
        if (!isv) { const int kt = f >> 4, ks = f & 15;
            const bf16_t* Km = (const bf16_t*)(F.ws + WS_KMEM) + (size_t)l * MEMROWS * DM;
            const u32x4 v = *(const u32x4*)(Km + (size_t)(b * MEMLEN + 32 * kt + r) * DM + 256 * hd + 16 * ks + 8 * h);
            *(u32x4*)(F.ws + WS_KF + (size_t)l * MiB + (size_t)c * 16) = v; }
        else { const int dt = f >> 4, kt = (f >> 1) & 7, s = f & 1;
            const bf16_t* Vt = (const bf16_t*)(F.ws + WS_VMEMT) + (size_t)l * DM * MEMROWS;
            const bf16_t* vrow = Vt + (size_t)(256 * hd + 32 * dt + r) * MEMROWS + b * MEMLEN + 32 * kt + 16 * s + 4 * h;
            const u32x2 lo = *(const u32x2*)(vrow), hi = *(const u32x2*)(vrow + 8);
            u32x4 v; v.x = lo.x; v.y = lo.y; v.z = hi.x; v.w = hi.y;
            *(u32x4*)(F.ws + WS_VF + (size_t)l * MiB + (size_t)c * 16) = v; }
    }
}

DI void xa_unit(Frame& F, int layer, int pm, int hd) {
    int tid = F.tid; asm volatile("" : "+v"(tid));
    const int lane = tid & 63, wave = F.wave, r = lane & 31, h = lane >> 5, b = pm >> 5;
    const bf16_t* Q = (const bf16_t*)(F.ws + WS_Q); bf16_t* Oo = (bf16_t*)(F.ws + WS_O);
    const unsigned char* KF = F.ws + WS_KF + (size_t)layer * MiB + (size_t)(b * 4 + hd) * 131072;
    const unsigned char* VF = F.ws + WS_VF + (size_t)layer * MiB + (size_t)(b * 4 + hd) * 131072;
    const int q0 = pm * 256 + wave * 32; const unsigned t16 = 16u * tid;
    LAS unsigned char* lds = F.lds;
    LAS unsigned char* wlo = lds + t16; unsigned whi_ = (unsigned)(size_t)(lds + 65536 + t16); asm volatile("" : "+v"(whi_)); LAS unsigned char* whi = (LAS unsigned char*)(size_t)whi_;
    LAS unsigned char* rlo = lds + lane * 16; unsigned rhi_ = (unsigned)(size_t)(lds + 65536 + lane * 16); asm volatile("" : "+v"(rhi_)); LAS unsigned char* rhi = (LAS unsigned char*)(size_t)rhi_;
    {
        u32x4 v[16];
#pragma unroll
        for (int i = 0; i < 16; ++i) v[i] = *(const u32x4*)(KF + (unsigned)i * 8192u + t16);
#pragma unroll
        for (int i = 0; i < 16; ++i) *(LAS u32x4*)((i < 8 ? wlo : whi) + (i & 7) * 8192) = v[i];
    }
    bf16x8 Qf[16];
#pragma unroll
    for (int ks = 0; ks < 16; ++ks) Qf[ks] = *(const bf16x8*)(Q + (size_t)(q0 + r) * DM + 256 * hd + 16 * ks + 8 * h);
    __syncthreads();
    f32x16 S[8];
#pragma unroll
    for (int kt = 0; kt < 8; ++kt)
#pragma unroll
        for (int i = 0; i < 16; ++i) S[kt][i] = 0.f;
    {
        bf16x8 fa[2][4];
#pragma unroll
        for (int j = 0; j < 4; ++j) fa[0][j] = *(const LAS bf16x8*)(rlo + j * 1024);
#pragma unroll
        for (int g = 0; g < 32; ++g) {
            if (g + 1 < 32) {
#pragma unroll
                for (int j = 0; j < 4; ++j) { const int f = (g + 1) * 4 + j; fa[(g + 1) & 1][j] = *(const LAS bf16x8*)((f < 64 ? rlo : rhi) + (f & 63) * 1024); }
            }
            __builtin_amdgcn_sched_barrier(0);
#pragma unroll
            for (int j = 0; j < 4; ++j) { const int f = g * 4 + j, kt = f >> 4, ks = f & 15; S[kt] = MFMA32(fa[g & 1][j], Qf[ks], S[kt]); }
            __builtin_amdgcn_sched_barrier(0);
        }
    }
    float mx = -1e30f;
#pragma unroll
    for (int kt = 0; kt < 8; ++kt)
#pragma unroll
        for (int i = 0; i < 16; ++i) mx = max_f(mx, S[kt][i]);
    mx = xmax32(mx);
    float sum = 0.f;
    bf16x8 pb[8][2];
#pragma unroll
    for (int kt = 0; kt < 8; ++kt) {
#pragma unroll
        for (int i = 0; i < 16; ++i) { const float e = __expf(S[kt][i] - mx); S[kt][i] = e; sum += e; }
        pb[kt][0] = pack8(S[kt], 0); pb[kt][1] = pack8(S[kt], 1);
    }
    sum = xsum32(sum);
    const float inv = 1.f / sum;
    __syncthreads();
    {
        u32x4 v[16];
#pragma unroll
        for (int i = 0; i < 16; ++i) v[i] = *(const u32x4*)(VF + (unsigned)i * 8192u + t16);
#pragma unroll
        for (int i = 0; i < 16; ++i) *(LAS u32x4*)((i < 8 ? wlo : whi) + (i & 7) * 8192) = v[i];
    }
    __syncthreads();
    f32x16 O[8];
#pragma unroll
    for (int dt = 0; dt < 8; ++dt)
#pragma unroll
        for (int i = 0; i < 16; ++i) O[dt][i] = 0.f;
    {
        bf16x8 fa[2][4];
#pragma unroll
        for (int j = 0; j < 4; ++j) fa[0][j] = *(const LAS bf16x8*)(rlo + j * 1024);
#pragma unroll
        for (int g = 0; g < 32; ++g) {
            if (g + 1 < 32) {
#pragma unroll
                for (int j = 0; j < 4; ++j) { const int f = (g + 1) * 4 + j; fa[(g + 1) & 1][j] = *(const LAS bf16x8*)((f < 64 ? rlo : rhi) + (f & 63) * 1024); }
            }
            __builtin_amdgcn_sched_barrier(0);
#pragma unroll
            for (int j = 0; j < 4; ++j) { const int f = g * 4 + j, dt = f >> 4, kt = (f >> 1) & 7, s2 = f & 1; O[dt] = MFMA32(fa[g & 1][j], pb[kt][s2], O[dt]); }
            __builtin_amdgcn_sched_barrier(0);
        }
    }
    __syncthreads();
    LAS bf16_t* tile = (LAS bf16_t*)(lds + wave * 16896);
#pragma unroll
    for (int dt = 0; dt < 8; ++dt)
#pragma unroll
        for (int g = 0; g < 4; ++g) { u32x2 v; v.x = pk2(O[dt][4 * g] * inv, O[dt][4 * g + 1] * inv); v.y = pk2(O[dt][4 * g + 2] * inv, O[dt][4 * g + 3] * inv);
            *(LAS u32x2*)(tile + r * 264 + 32 * dt + 8 * g + 4 * h) = v; }
    asm volatile("s_waitcnt lgkmcnt(0)" ::: "memory");
#pragma unroll
    for (int hb = 0; hb < 2; ++hb) {
        u32x4 v[8];
#pragma unroll
        for (int k = 0; k < 8; ++k) { const int c = (hb * 8 + k) * 64 + lane, row = c >> 5, c16 = c & 31; v[k] = *(const LAS u32x4*)(tile + row * 264 + c16 * 8); }
        __builtin_amdgcn_sched_barrier(0);
#pragma unroll
        for (int k = 0; k < 8; ++k) { const int c = (hb * 8 + k) * 64 + lane, row = c >> 5, c16 = c & 31; *(u32x4*)(Oo + (size_t)(q0 + row) * DM + 256 * hd + c16 * 8) = v[k]; }
    }
    asm volatile("s_waitcnt lgkmcnt(0)" ::: "memory");
}

#ifndef PROBE_PHASE
#define PROBE_PHASE (-1)
#endif
#ifndef PROBE_N
#define PROBE_N 2
#endif
constexpr int CW_BAR = 4096;
constexpr size_t WS_DUMMY = 244 * MiB;
__global__ void __launch_bounds__(512, 2) fwd_kernel(Params p) {
    extern __shared__ __attribute__((aligned(16))) unsigned char lds_raw[];
    cg::grid_group grid = cg::this_grid();
    Frame F;
    const int s_wave = __builtin_amdgcn_readfirstlane((int)threadIdx.x >> 6);
#define FRESH() do { unsigned z_ = 0u; asm volatile("" : "+v"(z_)); int sw_ = s_wave; asm volatile("" : "+s"(sw_)); \
        const int t_ = sw_ * 64 + (int)__builtin_amdgcn_mbcnt_hi(~0u, __builtin_amdgcn_mbcnt_lo(~0u, z_)); __attribute__((address_space(1))) unsigned char* w_ = (__attribute__((address_space(1))) unsigned char*)p.ws; asm volatile("" : "+s"(w_));   \
        LAS unsigned char* l_ = (LAS unsigned char*)lds_raw; asm volatile("" : "+s"(l_)); F.lds = l_; F.ws = (unsigned char*)w_; F.tid = t_; F.lane = t_ & 63; F.wave = __builtin_amdgcn_readfirstlane(t_ >> 6); F.G = gridDim.x; F.bid = blockIdx.x; } while (0)
#define XB ((bf16_t*)(F.ws + WS_XB))
#define H ((bf16_t*)(F.ws + WS_H))
#define PART ((float*)(F.ws + WS_PART))
#define SA ((bf16_t*)(F.ws + WS_SLOTA))
#define SB ((bf16_t*)(F.ws + WS_SLOTB))
#define XM (p.out)
#define ring (F.lds)
    volatile LAS unsigned* barst = (volatile LAS unsigned*)((LAS unsigned char*)lds_raw + LDS_BYTES - 64);
    if (threadIdx.x < 2) barst[threadIdx.x] = 0u;
    __syncthreads();
    XcdBarrier bar = xcd_barrier_post((unsigned*)(p.ws + WS_CTL) + CW_BAR, barst);
#define SYNC() do { FRESH(); xcd_barrier(bar, F.tid); FRESH(); } while (0)
#define SYNCC(LAYER, ID) do { FRESH(); \
        const ConvJob cj_ = conv_job(F, p, (LAYER), (ID)); const int cit_ = F.bid * 7 + F.wave - 1; const bool chas_ = F.wave >= 1 && cit_ < (cj_.K / 64) * (cj_.Ndst / 64); \
        xcd_barrier_a(bar, F.tid); \
        float cv_[64], ck_ = 0.f; \
        if (F.wave >= 1) conv_load(cj_, chas_ ? cit_ : 0, F.lane, cv_, ck_); \
        else { _Pragma("unroll") for (int i_ = 0; i_ < 64; ++i_) cv_[i_] = 0.f; } \
        xcd_barrier_b(bar, F.tid); FRESH(); \
        if (chas_) { LAS unsigned* scr_ = (LAS unsigned*)(F.lds + F.wave * 16384); \
            if (cj_.gain) conv_finish<true>(cj_, scr_, cit_, F.lane, cv_, ck_); else conv_finish<false>(cj_, scr_, cit_, F.lane, cv_, ck_); } \
        __syncthreads(); FRESH(); } while (0)
#define REP(id) for (int rep_ = 0; rep_ < ((PROBE_PHASE == (id) && l == 0) ? PROBE_N : 1); ++rep_)
    FRESH();
    { const int l = 0; REP(0) {
    prologue(F, p);
    if (p.pad0 != 0) grid.sync();
    SYNCC(0, 1); } }
#pragma unroll 1
    for (int l = 0; l < DEPTH; ++l) {
        REP(2) {
        { pg8::Gemm g{XB, SA, MTOK, 2 * FF, DM}; pg8::StaticOrder S; S.init(MTOK, 2 * FF, F.G, F.bid); pg8::EpiSwiglu E{H, PART, FF};
          pg8::gemm_phase<pg8::EpiSwiglu, pg8::StaticOrder, true, true>(ring, g, S, E, F.tid); }
        FRESH();
        if (l == 0 && F.G == 256 && F.bid >= 128 && F.bid < 160) {
            const int j = (F.bid - 128) >> 3, c8 = (F.bid - 128) & 7, ll = j >> 1, isv = j & 1;
            const bf16_t* memn = (const bf16_t*)(F.ws + WS_MEMN) + (size_t)ll * MEMROWS * DM;
            const bf16_t* Wt = (const bf16_t*)(F.ws + WS_WKV) + (size_t)(2 * ll + isv) * DM * DM;
            pg8::StaticOrder S2;
            if (!isv) { pg8::Gemm g2{memn, Wt, MEMROWS, DM, DM}; S2.init(MEMROWS, DM, 8, c8);
                pg8::EpiScale E2{(bf16_t*)(F.ws + WS_KMEM) + (size_t)ll * MEMROWS * DM, DM, 0, nullptr, 1.f, nullptr, 1 << 30};
                pg8::gemm_phase<pg8::EpiScale, pg8::StaticOrder, true, true>(ring, g2, S2, E2, F.tid); }
            else { pg8::Gemm g2{Wt, memn, DM, MEMROWS, DM}; S2.init(DM, MEMROWS, 8, c8);
                pg8::EpiScale E2{(bf16_t*)(F.ws + WS_VMEMT) + (size_t)ll * DM * MEMROWS, MEMROWS, 0, nullptr, 1.f, nullptr, 1 << 30};
                pg8::gemm_phase<pg8::EpiScale, pg8::StaticOrder, true, true>(ring, g2, S2, E2, F.tid); }
        }
        SYNCC(l, 2); }
        REP(3) {
        { pg8::Gemm g{H, SB, MTOK, DM, FF}; pg8::StaticOrder S; S.init(MTOK, DM, F.G, F.bid); pg8::EpiResid E{(l == 0 && rep_ == 0) ? p.in[0] : nullptr, XB, PART, 0.5f, rep_ > 0};
          pg8::gemm_phase<pg8::EpiResid, pg8::StaticOrder, true, true>(ring, g, S, E, F.tid); }
        SYNCC(l, 3); }
        REP(4) {
        if (l == 0) { xa_relayout(F); __syncthreads(); }
        { pg8::Gemm g{XB, SA, MTOK, NMIXP, DM}; pg8::StaticOrder S; S.init(MTOK, NMIXP, F.G, F.bid);
          pg8::EpiScale E{(bf16_t*)(F.ws + WS_P), 256, (size_t)MTOK * 256, PART, 1.f, (float*)(F.ws + WS_PF), 11};
          pg8::gemm_phase<pg8::EpiScale, pg8::StaticOrder, true, true>(ring, g, S, E, F.tid); }
        SYNC(); }
        REP(5) {
        phase_prep(F, p, l);
        SYNC(); }
        REP(6) {
        phase_mix(F, p, l, 2 * l + rep_);
        SYNCC(l, 4); }
        REP(7) {
        { pg8::Gemm g{(const bf16_t*)(F.ws + WS_Y), SB, MTOK, DM, DM}; pg8::StaticOrder S; S.init(MTOK, DM, F.G, F.bid); pg8::EpiResid E{nullptr, XB, PART, 1.f, rep_ > 0};
          pg8::gemm_phase<pg8::EpiResid, pg8::StaticOrder, true, true>(ring, g, S, E, F.tid); }
        SYNCC(l, 5); }
        REP(8) {
        { pg8::Gemm g{XB, SA, MTOK, DM, DM}; pg8::StaticOrder S; S.init(MTOK, DM, F.G, F.bid);
          pg8::EpiScale E{(bf16_t*)(F.ws + WS_Q), DM, 0, PART, 0.0625f, nullptr, 1 << 30};
          pg8::gemm_phase<pg8::EpiScale, pg8::StaticOrder, true, true>(ring, g, S, E, F.tid); }
        SYNC(); }
        REP(9) {
        for (int u = F.bid; u < 256; u += F.G) { xa_unit(F, l, u >> 2, u & 3); __syncthreads(); }
        SYNCC(l, 6); }
        REP(10) {
        { pg8::Gemm g{(const bf16_t*)(F.ws + WS_O), SB, MTOK, DM, DM}; pg8::StaticOrder S; S.init(MTOK, DM, F.G, F.bid); pg8::EpiResid E{nullptr, XB, PART, 1.f, rep_ > 0};
          pg8::gemm_phase<pg8::EpiResid, pg8::StaticOrder, true, true>(ring, g, S, E, F.tid); }
        SYNCC(l, 7); }
        REP(11) {
        { pg8::Gemm g{XB, SA, MTOK, 2 * FF, DM}; pg8::StaticOrder S; S.init(MTOK, 2 * FF, F.G, F.bid); pg8::EpiSwiglu E{H, PART, FF};
          pg8::gemm_phase<pg8::EpiSwiglu, pg8::StaticOrder, true, true>(ring, g, S, E, F.tid); }
        if (l + 1 < DEPTH) SYNCC(l + 1, 0); else SYNC(); }
        REP(12) {
        { pg8::Gemm g{H, SB, MTOK, DM, FF}; pg8::StaticOrder S; S.init(MTOK, DM, F.G, F.bid); pg8::EpiResid E{nullptr, XB, PART, 0.5f, rep_ > 0};
          pg8::gemm_phase<pg8::EpiResid, pg8::StaticOrder, true, true>(ring, g, S, E, F.tid); }
        if (l + 1 < DEPTH) SYNCC(l + 1, 1); else SYNC(); }
    }
    {
        const int gw = F.bid * 8 + F.wave, NGW = F.G * 8, lane = F.lane;
        for (int m0 = gw; m0 < MTOK; m0 += 2 * NGW) {
            u32x2 v[2][4]; float rstd[2];
#pragma unroll
            for (int k = 0; k < 2; ++k) { const int mrow = m0 + k * NGW;
                const f32x4* pp = (const f32x4*)(PART + (size_t)mrow * 16);
                const f32x4 a = pp[0], b = pp[1], c = pp[2], d = pp[3];
                const float s = (((a[0] + a[1]) + (a[2] + a[3])) + ((b[0] + b[1]) + (b[2] + b[3]))) + (((c[0] + c[1]) + (c[2] + c[3])) + ((d[0] + d[1]) + (d[2] + d[3])));
                rstd[k] = rsqrtf(s * (1.f / DM) + EPS);
                const u32x2* xr = (const u32x2*)(XB + (size_t)mrow * DM) + lane;
#pragma unroll
                for (int j = 0; j < 4; ++j) v[k][j] = xr[64 * j]; }
            const f32x4* gr = (const f32x4*)p.in[32] + lane;
#pragma unroll
            for (int k = 0; k < 2; ++k) { f32x4* orow = (f32x4*)(XM + (size_t)(m0 + k * NGW) * DM) + lane;
#pragma unroll
                for (int j = 0; j < 4; ++j) { const f32x4 xv = {bflo(v[k][j].x), bfhi(v[k][j].x), bflo(v[k][j].y), bfhi(v[k][j].y)}; orow[64 * j] = xv * rstd[k] * gr[64 * j]; } }
        }
    }
}

extern "C" void kernel_launch(void* const* d_in, const int* in_sizes, int n_in, void* d_out, int out_size, void* d_ws, size_t ws_size, hipStream_t stream) {
    static int grid_blocks = 0;
    if (!grid_blocks) {
        int dev = 0, cus = 0, per_cu = 0;
        if (n_in != 33 || out_size != MTOK * DM || ws_size < WS_END) { fprintf(stderr, "kernel_launch: unexpected sizes n_in %d out %d ws %zu (need %zu)\n", n_in, out_size, ws_size, (size_t)WS_END); grid_blocks = -1; return; }
        (void)hipGetDevice(&dev);
        (void)hipDeviceGetAttribute(&cus, hipDeviceAttributeMultiprocessorCount, dev);
        (void)hipFuncSetAttribute((const void*)fwd_kernel, hipFuncAttributeMaxDynamicSharedMemorySize, LDS_BYTES);
        (void)hipOccupancyMaxActiveBlocksPerMultiprocessor(&per_cu, fwd_kernel, 512, LDS_BYTES);
        fprintf(stderr, "kernel_launch: cus %d per_cu %d ws %zu\n", cus, per_cu, ws_size);
        grid_blocks = (per_cu >= 1) ? cus : -1;
    }
    if (grid_blocks < 0) return;
    (void)hipMemsetAsync((char*)d_ws + WS_CTL, 0, 65536, stream);
    Params p{};
    for (int i = 0; i < 33; ++i) p.in[i] = (const float*)d_in[i];
    p.out = (float*)d_out; p.ws = (unsigned char*)d_ws;
    void* args[] = {&p};
    hipError_t e = hipLaunchCooperativeKernel((void*)fwd_kernel, dim3(grid_blocks), dim3(512), args, LDS_BYTES, stream);
    if (e != hipSuccess) fprintf(stderr, "cooperative launch failed: %s (grid %d)\n", hipGetErrorString(e), grid_blocks);
}
```
